# Optimizing an MI355X kernel written in HIP

```python
import math
import jax, jax.numpy as jnp
from jax import lax
import numpy as np

D_MODEL = 2048
BATCH = 8
SEQ = 2048
DEPTH = 1

MIX_WIDTH = D_MODEL
ATTN_WIDTH = MIX_WIDTH // 2
HYENA_WIDTH = MIX_WIDTH - ATTN_WIDTH
N_HEADS = 8
HEAD_DIM = ATTN_WIDTH // N_HEADS // 2
V_HEAD_DIM = 2 * HEAD_DIM
Q_BLOCK = 128
SHORT_CONV = 3
FILTER_EMB = 33
FILTER_HIDDEN = 64
DECAY_FAST = 0.3
DECAY_SLOW = 1.5
DECAY_TARGET = 1e-2
DECAY_SHIFT = 0.0
D_FF = 4 * D_MODEL
ALPHA = (2.0 * DEPTH) ** 0.25
BETA = (8.0 * DEPTH) ** -0.25
EPS = 1e-5
IN_COLS = 3 * ATTN_WIDTH + 3 * HYENA_WIDTH

kernel_name = "hymba_diffattn_hyena_deepnorm_encoder"


def layer_norm(x, g, b):
    xf = x.astype(jnp.float32)
    mu = jnp.mean(xf, axis=-1, keepdims=True)
    var = jnp.mean(jnp.square(xf - mu), axis=-1, keepdims=True)
    y = (xf - mu) * lax.rsqrt(var + EPS) * g.astype(jnp.float32) + b.astype(jnp.float32)
    return y.astype(x.dtype)


def rms_norm(x, g):
    xf = x.astype(jnp.float32)
    y = xf * lax.rsqrt(jnp.mean(jnp.square(xf), axis=-1, keepdims=True) + EPS)
    return y * g.astype(jnp.float32)


def alibi_slopes(n_heads):
    return jnp.asarray(np.array([2.0 ** (-8.0 * (h + 1) / n_heads) for h in range(n_heads)], dtype=np.float32))


def diff_attention(q, k, v, lam, slopes):
    B, S = q.shape[0], q.shape[1]
    nb = S // Q_BLOCK
    scale = HEAD_DIM ** -0.5
    qb = jnp.moveaxis(q.reshape(B, nb, Q_BLOCK, N_HEADS, 2, HEAD_DIM), 1, 0)
    starts = jnp.arange(nb, dtype=jnp.int32) * Q_BLOCK
    key_pos = jnp.arange(S, dtype=jnp.int32)

    def block(args):
        q_i, start = args
        s = jnp.einsum("bqhcd,bkhcd->bhcqk", q_i, k, preferred_element_type=jnp.float32) * scale
        q_pos = start + jnp.arange(Q_BLOCK, dtype=jnp.int32)
        dist = jnp.abs(q_pos[:, None] - key_pos[None, :]).astype(jnp.float32)
        s = s - slopes[None, :, None, None, None] * dist[None, None, None]
        p = jax.nn.softmax(s, axis=-1)
        a = p[:, :, 0] - lam * p[:, :, 1]
        return jnp.einsum("bhqk,bkhe->bqhe", a.astype(v.dtype), v, preferred_element_type=jnp.float32)

    o = lax.map(block, (qb, starts))
    return jnp.moveaxis(o, 0, 1).reshape(B, S, N_HEADS, V_HEAD_DIM)


def hyena_filters(L, w1, b1, freq, w2, b2, w3):
    f32 = jnp.float32
    t = jnp.linspace(0.0, 1.0, L, dtype=f32)[:, None]
    bands = (FILTER_EMB - 1) // 2
    w = 2.0 * math.pi * jnp.arange(L, dtype=f32)[:, None] / L
    f = jnp.linspace(1e-4, bands - 1, bands, dtype=f32)[None, :]
    z = jnp.concatenate([t, jnp.cos(f * w), -jnp.sin(f * w)], axis=-1)
    fr = freq.astype(f32)
    h = jnp.sin(fr * (z @ w1.astype(f32) + b1.astype(f32)))
    h = jnp.sin(fr * (h @ w2.astype(f32) + b2.astype(f32)))
    h = h @ w3.astype(f32)
    max_decay = math.log(DECAY_TARGET) / DECAY_FAST
    min_decay = math.log(DECAY_TARGET) / DECAY_SLOW
    deltas = jnp.linspace(min_decay, max_decay, HYENA_WIDTH, dtype=f32)
    decay = jnp.exp(-t * jnp.abs(deltas)[None, :])
    h = h * (jnp.tile(decay, (1, 2)) + DECAY_SHIFT)
    return h[:, :HYENA_WIDTH], h[:, HYENA_WIDTH:]


def hyena_mixer(u, conv_w, conv_b, w1, b1, freq, w2, b2, w3, d_skip):
    L = u.shape[1]
    pad = SHORT_CONV // 2
    up = jnp.pad(u, ((0, 0), (pad, pad), (0, 0)))
    z = conv_b
    for j in range(SHORT_CONV):
        z = z + up[:, j:j + L] * conv_w[j]
    x1, x2, v = jnp.split(z, 3, axis=-1)
    hf, hb = hyena_filters(L, w1, b1, freq, w2, b2, w3)
    kern = jnp.concatenate([hf, jnp.zeros((1, HYENA_WIDTH), jnp.float32), hb[1:][::-1]], axis=0)
    n = 2 * L
    vg = (v * x2).astype(jnp.float32)
    y = jnp.fft.irfft(jnp.fft.rfft(vg, n=n, axis=1) * jnp.fft.rfft(kern, n=n, axis=0)[None], n=n, axis=1)[:, :L]
    y = y + vg * d_skip.astype(jnp.float32)
    return y * x1.astype(jnp.float32)


def setup_inputs(seed: int = 0) -> dict:
    key = jax.random.key(seed)
    ks = jax.random.split(key, 26)
    nrm = lambda k, s: jax.random.normal(k, s, dtype=jnp.float32)
    col_scale = np.ones((IN_COLS,), dtype=np.float32)
    col_scale[2 * ATTN_WIDTH:3 * ATTN_WIDTH] = BETA
    col_scale[3 * ATTN_WIDTH + 2 * HYENA_WIDTH:] = BETA
    return {
        "x": nrm(ks[0], (BATCH, SEQ, D_MODEL)),
        "w_in": nrm(ks[1], (DEPTH, D_MODEL, IN_COLS)) * (D_MODEL ** -0.5) * jnp.asarray(col_scale),
        "lambda_q1": nrm(ks[2], (DEPTH, HEAD_DIM)) * 0.1,
        "lambda_k1": nrm(ks[3], (DEPTH, HEAD_DIM)) * 0.1,
        "lambda_q2": nrm(ks[4], (DEPTH, HEAD_DIM)) * 0.1,
        "lambda_k2": nrm(ks[5], (DEPTH, HEAD_DIM)) * 0.1,
        "subln_g": 1.0 + 0.02 * nrm(ks[6], (DEPTH, V_HEAD_DIM)),
        "conv_w": nrm(ks[7], (DEPTH, SHORT_CONV, 3 * HYENA_WIDTH)) * (SHORT_CONV ** -0.5),
        "conv_b": 0.02 * nrm(ks[8], (DEPTH, 3 * HYENA_WIDTH)),
        "filt_w1": nrm(ks[9], (DEPTH, FILTER_EMB, FILTER_HIDDEN)) * (FILTER_EMB ** -0.5),
        "filt_b1": 0.1 * nrm(ks[10], (DEPTH, FILTER_HIDDEN)),
        "filt_freq": 1.0 + 0.01 * nrm(ks[11], (DEPTH, FILTER_HIDDEN)),
        "filt_w2": nrm(ks[12], (DEPTH, FILTER_HIDDEN, FILTER_HIDDEN)) * (FILTER_HIDDEN ** -0.5),
        "filt_b2": 0.1 * nrm(ks[13], (DEPTH, FILTER_HIDDEN)),
        "filt_w3": nrm(ks[14], (DEPTH, FILTER_HIDDEN, 2 * HYENA_WIDTH)) * (FILTER_HIDDEN ** -0.5) * 0.1,
        "hyena_skip": nrm(ks[15], (DEPTH, HYENA_WIDTH)),
        "hyena_gain": 1.0 + 0.02 * nrm(ks[16], (DEPTH, HYENA_WIDTH)),
        "w_out": nrm(ks[17], (DEPTH, MIX_WIDTH, D_MODEL)) * (MIX_WIDTH ** -0.5) * BETA,
        "ln1_g": 1.0 + 0.02 * nrm(ks[18], (DEPTH, D_MODEL)),
        "ln1_b": 0.02 * nrm(ks[19], (DEPTH, D_MODEL)),
        "w_ff1": nrm(ks[20], (DEPTH, D_MODEL, D_FF)) * (D_MODEL ** -0.5) * BETA,
        "w_ff2": nrm(ks[21], (DEPTH, D_FF, D_MODEL)) * (D_FF ** -0.5) * BETA,
        "ln2_g": 1.0 + 0.02 * nrm(ks[22], (DEPTH, D_MODEL)),
        "ln2_b": 0.02 * nrm(ks[23], (DEPTH, D_MODEL)),
    }


def reference(x, w_in, lambda_q1, lambda_k1, lambda_q2, lambda_k2, subln_g, conv_w, conv_b,
              filt_w1, filt_b1, filt_freq, filt_w2, filt_b2, filt_w3, hyena_skip, hyena_gain,
              w_out, ln1_g, ln1_b, w_ff1, w_ff2, ln2_g, ln2_b):
    B, S, _ = x.shape
    A = ATTN_WIDTH
    slopes = alibi_slopes(N_HEADS)
    for l in range(DEPTH):
        lam_init = 0.8 - 0.6 * math.exp(-0.3 * l)
        proj = jnp.einsum("bsd,dn->bsn", x, w_in[l])
        q = proj[..., :A].reshape(B, S, N_HEADS, 2, HEAD_DIM)
        k = proj[..., A:2 * A].reshape(B, S, N_HEADS, 2, HEAD_DIM)
        v = proj[..., 2 * A:3 * A].reshape(B, S, N_HEADS, V_HEAD_DIM)
        lam = (jnp.exp(jnp.sum(lambda_q1[l].astype(jnp.float32) * lambda_k1[l].astype(jnp.float32)))
               - jnp.exp(jnp.sum(lambda_q2[l].astype(jnp.float32) * lambda_k2[l].astype(jnp.float32)))
               + lam_init)
        att = diff_attention(q, k, v, lam, slopes)
        att = (rms_norm(att, subln_g[l]) * (1.0 - lam_init)).reshape(B, S, A).astype(x.dtype)
        hy = hyena_mixer(proj[..., 3 * A:], conv_w[l], conv_b[l], filt_w1[l], filt_b1[l], filt_freq[l],
                         filt_w2[l], filt_b2[l], filt_w3[l], hyena_skip[l])
        hy = rms_norm(hy, hyena_gain[l]).astype(x.dtype)
        mix = jnp.einsum("bsm,md->bsd", jnp.concatenate([att, hy], axis=-1), w_out[l])
        x = layer_norm(ALPHA * x + mix, ln1_g[l], ln1_b[l])
        h = jnp.square(jax.nn.relu(jnp.einsum("bsd,df->bsf", x, w_ff1[l])))
        x = layer_norm(ALPHA * x + jnp.einsum("bsf,fd->bsd", h, w_ff2[l]), ln2_g[l], ln2_b[l])
    return x
```

```cpp
#include <hip/hip_runtime.h>
#include <hip/hip_cooperative_groups.h>
#include <cstdio>
#include <cstdint>
namespace cg = cooperative_groups;
namespace pg8 {
#define PG8_LAS __attribute__((address_space(3)))
typedef unsigned short bf16_t;
typedef short bf16x8 __attribute__((ext_vector_type(8)));
typedef float f32x4 __attribute__((ext_vector_type(4)));
typedef unsigned u32x4 __attribute__((ext_vector_type(4)));
constexpr int BM = 256, BK = 64, HALF = 128, HTB = HALF * BK * 2  , STAGE_BYTES = 8 * HTB, NXCD = 8, WGM = 8;

__host__ __device__ __forceinline__ int lds_byte(int r, int c) { const int st = (r >> 4) * 2 + (c >> 5), rr = r & 15, cc = c & 31, ob = rr * 64 + cc * 2; return st * 1024 + (ob ^ (((ob >> 9) & 1) << 5)); }
__host__ __device__ __forceinline__ void stage_rc(int b, int& R, int& C) { const int st = b / 1024, sb = b % 1024, swz = sb ^ (((sb >> 9) & 1) << 5); R = (st >> 1) * 16 + swz / 64; C = (st & 1) * 32 + (swz % 64) / 2; }
__host__ __device__ __forceinline__ int perm32(int rho) { const int n = rho >> 4, i = rho & 15; return 8 * (i >> 2) + 4 * n + (i & 3); }

struct Unit { int pm, pn; };
struct Gemm { const bf16_t* A; const bf16_t* Bt; int M, N, K; };

struct StaticOrder {
    int nM, nN, nwg, G, c;
    __host__ __device__ void init(int M, int N, int G_, int c_) { nM = M / BM; nN = N / BM; nwg = nM * nN; G = G_; c = c_; }
    __host__ __device__ bool next(int i, Unit& u) const {
        const long L = (long)i * G + c; if (L >= nwg) return false;
        int wgid = (int)L; { const int q = nwg / NXCD, r = nwg % NXCD, xcd = wgid % NXCD, off = wgid / NXCD; wgid = (xcd < r ? xcd * (q + 1) : r * (q + 1) + (xcd - r) * q) + off; }
        const int nig = WGM * nN, gid = wgid / nig, fm = gid * WGM, gsz = (nM - fm) < WGM ? (nM - fm) : WGM;
        u.pm = fm + ((wgid % nig) % gsz); u.pn = (wgid % nig) / gsz; return true;
    }
    __device__ __forceinline__ void a_ready(const Unit&) const {}
    __device__ __forceinline__ void done(const Unit&) const {}
};

__device__ __forceinline__ unsigned cvt_pk_bf16(float lo, float hi) { unsigned r; asm volatile("v_cvt_pk_bf16_f32 %0, %1, %2" : "=v"(r) : "v"(lo), "v"(hi)); return r; }
typedef float f32x2 __attribute__((ext_vector_type(2)));
template <int ACT> struct EpiBf16 {
    static constexpr bool PERM = true, AFTER_DRAIN = false;
    bf16_t* O; int ldc; int scale_cols; float scale0;
    __device__ __forceinline__ void operator()(const f32x4 (&acc)[2][2][4][2], const Unit& u, int wr, int wc, int fr, int fq) const {
        const int row0 = u.pm * BM + wr * 64 + fr; const int colt = u.pn * BM;
        const float sc = (colt < scale_cols) ? scale0 : 1.f;
        const int col0 = colt + wc * 32 + 8 * fq;
#pragma unroll
        for (int ai = 0; ai < 2; ++ai)
#pragma unroll
            for (int m = 0; m < 4; ++m) { bf16_t* rowp = O + (size_t)(row0 + ai * HALF + m * 16) * ldc + col0;
#pragma unroll
                for (int bj = 0; bj < 2; ++bj) { f32x4 v0 = acc[ai][bj][m][0], v1 = acc[ai][bj][m][1];
                    if (ACT == 2) {
#pragma unroll
                        for (int e = 0; e < 4; ++e) { const float a = v0[e] > 0.f ? v0[e] : 0.f, b = v1[e] > 0.f ? v1[e] : 0.f; v0[e] = a * a; v1[e] = b * b; } }
                    v0 = v0 * sc; v1 = v1 * sc; u32x4 w; w.x = cvt_pk_bf16(v0[0], v0[1]); w.y = cvt_pk_bf16(v0[2], v0[3]); w.z = cvt_pk_bf16(v1[0], v1[1]); w.w = cvt_pk_bf16(v1[2], v1[3]);
                    *(u32x4*)(rowp + bj * HALF) = w; } }
    }
};
struct EpiResF32 {
    static constexpr bool PERM = false, AFTER_DRAIN = false;
    const float* base; float* out; int ldc; float alpha;
    __device__ __forceinline__ void operator()(const f32x4 (&acc)[2][2][4][2], const Unit& u, int wr, int wc, int fr, int fq) const {
        const int col0 = u.pn * BM + wc * 32 + 4 * fq;
#pragma unroll
        for (int ai = 0; ai < 2; ++ai)
#pragma unroll
            for (int m = 0; m < 4; ++m) { const size_t off = (size_t)(u.pm * BM + ai * HALF + wr * 64 + m * 16 + fr) * ldc + col0;
#pragma unroll
                for (int bj = 0; bj < 2; ++bj)
#pragma unroll
                    for (int n = 0; n < 2; ++n) { const f32x4 bs = *(const f32x4*)(base + off + bj * HALF + n * 16); const f32x4 o = bs * alpha + acc[ai][bj][m][n]; *(f32x4*)(out + off + bj * HALF + n * 16) = o; }
                asm volatile("" ::: "memory"); }
    }
};
template <class Epi, class Sched, bool ALIGN_EPI = false, bool SP2 = false>
__device__ __forceinline__ void gemm_phase(PG8_LAS unsigned char* lds, const Gemm g, const Sched& S, const Epi& E) {
    const int tid = threadIdx.x, wid = __builtin_amdgcn_readfirstlane(tid >> 6), lane = tid & 63, wr = wid >> 2, wc = wid & 3, fr = lane & 15, fq = lane >> 4;
    const int K = g.K, nt = K / BK;
    unsigned voffA[2], voffB[2];
#pragma unroll
    for (int i = 0; i < 2; ++i) { int R, C; stage_rc(tid * 16 + i * 8192, R, C); const int Rb = Epi::PERM ? ((R & ~31) + perm32(R & 31)) : R;
        voffA[i] = (unsigned)(R * K + C) * 2u; voffB[i] = (unsigned)(Rb * K + C) * 2u; }
    const size_t kstep = (size_t)(BK * 2);
    const size_t hstep = (size_t)HALF * K * 2;
    const size_t tstep = 2 * hstep;
    const unsigned ldsw = (unsigned)wid * 1024u;
    const int aoff = lds_byte(wr * 64 + fr, fq * 8), boff = lds_byte(wc * 32 + fr, fq * 8);
#define PG8_SA(b, h) (((b) * 2 + (h)) * HTB)
#define PG8_SB(b, h) ((4 + (b) * 2 + (h)) * HTB)
#define PG8_STAGE(bufoff, gbase, voff) do { _Pragma("unroll") for (int _i = 0; _i < 2; ++_i) \
        __builtin_amdgcn_global_load_lds((const unsigned*)((const char*)(gbase) + (voff)[_i]), (PG8_LAS unsigned*)(lds + (bufoff) + ldsw + _i * 8192), 16, 0, 0); } while (0)
#define PG8_LDA(dst, b, h) do { _Pragma("unroll") for (int m = 0; m < 4; ++m) _Pragma("unroll") for (int k = 0; k < 2; ++k) dst[m][k] = *(const PG8_LAS bf16x8*)(lds + PG8_SA(b, h) + aoff + m * 2048 + k * 1024); } while (0)
#define PG8_LDB(dst, b, h) do { _Pragma("unroll") for (int n = 0; n < 2; ++n) _Pragma("unroll") for (int k = 0; k < 2; ++k) dst[n][k] = *(const PG8_LAS bf16x8*)(lds + PG8_SB(b, h) + boff + n * 2048 + k * 1024); } while (0)
#define PG8_MMA(ai, bj, At, Bt) do { __builtin_amdgcn_s_setprio(1); _Pragma("unroll") for (int m = 0; m < 4; ++m) _Pragma("unroll") for (int n = 0; n < 2; ++n) _Pragma("unroll") for (int k = 0; k < 2; ++k) \
        acc[ai][bj][m][n] = __builtin_amdgcn_mfma_f32_16x16x32_bf16(Bt[n][k], At[m][k], acc[ai][bj][m][n], 0, 0, 0); __builtin_amdgcn_s_setprio(0); } while (0)
#define PG8_WAIT_V(n) asm volatile("s_waitcnt vmcnt(" #n ")" ::: "memory")
#define PG8_WAIT_L(n) asm volatile("s_waitcnt lgkmcnt(" #n ")" ::: "memory")
#define PG8_BAR __builtin_amdgcn_s_barrier()
#define PG8_SCHED __builtin_amdgcn_sched_barrier(0)
    Unit cur, nxt; int ui = 0;
    if (!S.next(0, cur)) return;
    f32x4 acc[2][2][4][2];
#pragma unroll
    for (int a = 0; a < 2; ++a)
#pragma unroll
        for (int b = 0; b < 2; ++b)
#pragma unroll
            for (int m = 0; m < 4; ++m)
#pragma unroll
                for (int n = 0; n < 2; ++n) acc[a][b][m][n] = (f32x4){0.f, 0.f, 0.f, 0.f};
    bf16x8 At[4][2], B0[2][2], B1[2][2];
    const char* cA = (const char*)g.A + (size_t)cur.pm * tstep; const char* cB = (const char*)g.Bt + (size_t)cur.pn * tstep;
    S.a_ready(cur);
    if constexpr (SP2) {
        PG8_STAGE(PG8_SB(0, 0), cB, voffB); PG8_STAGE(PG8_SB(0, 1), cB + hstep, voffB); PG8_STAGE(PG8_SA(0, 0), cA, voffA); PG8_STAGE(PG8_SA(0, 1), cA + hstep, voffA);
        if (wr == 1) PG8_BAR;
        PG8_WAIT_V(2); PG8_BAR;
        PG8_STAGE(PG8_SB(1, 0), cB + kstep, voffB); PG8_STAGE(PG8_SA(1, 0), cA + kstep, voffA); PG8_STAGE(PG8_SB(1, 1), cB + hstep + kstep, voffB);
        PG8_WAIT_V(6); PG8_BAR;
    } else {
        PG8_STAGE(PG8_SB(0, 0), cB, voffB); PG8_STAGE(PG8_SA(0, 0), cA, voffA); PG8_STAGE(PG8_SB(0, 1), cB + hstep, voffB); PG8_STAGE(PG8_SA(0, 1), cA + hstep, voffA);
        if (wr == 1) PG8_BAR;
        PG8_WAIT_V(4); PG8_BAR;
        PG8_STAGE(PG8_SB(1, 0), cB + kstep, voffB); PG8_STAGE(PG8_SA(1, 0), cA + kstep, voffA); PG8_STAGE(PG8_SB(1, 1), cB + hstep + kstep, voffB);
        PG8_WAIT_V(6); PG8_BAR;
    }
    for (;;) {
        const bool has_next = S.next(ui + 1, nxt);
        const char* nA = has_next ? (const char*)g.A + (size_t)nxt.pm * tstep : cA; const char* nB = has_next ? (const char*)g.Bt + (size_t)nxt.pn * tstep : cB;
        for (int t = 0; t < nt; t += 2) {
            const bool last = (t == nt - 2);
            const char* a1 = cA + (size_t)(t + 1) * kstep;
            const char* a2 = last ? nA : cA + (size_t)(t + 2) * kstep; const char* b2 = last ? nB : cB + (size_t)(t + 2) * kstep;
            const char* a3 = a2 + kstep; const char* b3 = b2 + kstep;
            if (last && has_next) S.a_ready(nxt);
            if constexpr (SP2) {
            PG8_LDB(B0, 0, 0); PG8_LDB(B1, 0, 1); PG8_SCHED; PG8_LDA(At, 0, 0); PG8_STAGE(PG8_SA(1, 1), a1 + hstep, voffA);
            PG8_WAIT_V(8); PG8_WAIT_L(0); PG8_BAR; PG8_MMA(0, 0, At, B0); PG8_MMA(0, 1, At, B1); PG8_BAR; PG8_SCHED;
            PG8_LDA(At, 0, 1); PG8_STAGE(PG8_SB(0, 0), b2, voffB); PG8_STAGE(PG8_SB(0, 1), b2 + hstep, voffB); PG8_STAGE(PG8_SA(0, 0), a2, voffA);
            PG8_WAIT_V(8); PG8_WAIT_L(0); PG8_BAR; PG8_MMA(1, 0, At, B0); PG8_MMA(1, 1, At, B1); PG8_BAR; PG8_SCHED;
            PG8_LDB(B0, 1, 0); PG8_LDB(B1, 1, 1); PG8_SCHED; PG8_LDA(At, 1, 0); PG8_STAGE(PG8_SA(0, 1), a2 + hstep, voffA);
            PG8_WAIT_V(8); PG8_WAIT_L(0); PG8_BAR; PG8_MMA(0, 0, At, B0); PG8_MMA(0, 1, At, B1); PG8_BAR; PG8_SCHED;
            PG8_LDA(At, 1, 1); PG8_STAGE(PG8_SB(1, 0), b3, voffB); PG8_STAGE(PG8_SB(1, 1), b3 + hstep, voffB); PG8_STAGE(PG8_SA(1, 0), a3, voffA);
            PG8_WAIT_V(8); PG8_WAIT_L(0); PG8_BAR; PG8_MMA(1, 0, At, B0); PG8_MMA(1, 1, At, B1); PG8_BAR; PG8_SCHED;
            } else {
            PG8_LDB(B0, 0, 0); PG8_SCHED; PG8_LDA(At, 0, 0); PG8_STAGE(PG8_SA(1, 1), a1 + hstep, voffA);
            PG8_WAIT_L(8); PG8_BAR; PG8_WAIT_L(0); PG8_MMA(0, 0, At, B0); PG8_BAR; PG8_SCHED;
            PG8_LDB(B1, 0, 1); PG8_STAGE(PG8_SB(0, 0), b2, voffB);
            PG8_BAR; PG8_WAIT_L(0); PG8_MMA(0, 1, At, B1); PG8_BAR;
            PG8_LDA(At, 0, 1); PG8_STAGE(PG8_SA(0, 0), a2, voffA);
            PG8_BAR; PG8_WAIT_L(0); PG8_MMA(1, 0, At, B0); PG8_BAR; PG8_SCHED;
            PG8_STAGE(PG8_SB(0, 1), b2 + hstep, voffB);
            PG8_WAIT_V(6); PG8_BAR; PG8_MMA(1, 1, At, B1); PG8_BAR;
            PG8_LDB(B0, 1, 0); PG8_SCHED; PG8_LDA(At, 1, 0); PG8_STAGE(PG8_SA(0, 1), a2 + hstep, voffA);
            PG8_WAIT_L(8); PG8_BAR; PG8_WAIT_L(0); PG8_MMA(0, 0, At, B0); PG8_BAR; PG8_SCHED;
            PG8_LDB(B1, 1, 1); PG8_STAGE(PG8_SB(1, 0), b3, voffB);
            PG8_BAR; PG8_WAIT_L(0); PG8_MMA(0, 1, At, B1); PG8_BAR;
            PG8_LDA(At, 1, 1); PG8_STAGE(PG8_SA(1, 0), a3, voffA);
            PG8_BAR; PG8_WAIT_L(0); PG8_MMA(1, 0, At, B0); PG8_BAR; PG8_SCHED;
            PG8_STAGE(PG8_SB(1, 1), b3 + hstep, voffB);
            PG8_WAIT_V(6); PG8_BAR; PG8_MMA(1, 1, At, B1); PG8_BAR;
            }
        }
        if constexpr (ALIGN_EPI) { if (wr == 0) PG8_BAR; }
        if constexpr (!Epi::AFTER_DRAIN) { E(acc, cur, wr, wc, fr, fq); S.done(cur); }
        if (!has_next) break;
#pragma unroll
        for (int a = 0; a < 2; ++a)
#pragma unroll
            for (int b = 0; b < 2; ++b)
#pragma unroll
                for (int m = 0; m < 4; ++m)
#pragma unroll
                    for (int n = 0; n < 2; ++n) acc[a][b][m][n] = (f32x4){0.f, 0.f, 0.f, 0.f};
        cur = nxt; cA = nA; cB = nB; ++ui;
        if constexpr (ALIGN_EPI) { if (wr == 1) PG8_BAR; }
    }
    PG8_WAIT_V(0);
    if constexpr (!ALIGN_EPI) { if (wr == 0) PG8_BAR; }
    PG8_BAR;
    if constexpr (Epi::AFTER_DRAIN) { E.fused(acc, cur, wr, wc, fr, fq, lds, wid, lane); S.done(cur); }
#undef PG8_SA
#undef PG8_SB
#undef PG8_STAGE
#undef PG8_LDA
#undef PG8_LDB
#undef PG8_MMA
#undef PG8_WAIT_V
#undef PG8_WAIT_L
#undef PG8_BAR
#undef PG8_SCHED
}
}
#define LAS __attribute__((address_space(3)))
typedef pg8::bf16_t bf16;
typedef unsigned u32x4 __attribute__((ext_vector_type(4)));
typedef unsigned u32x2 __attribute__((ext_vector_type(2)));
typedef float f32x4 __attribute__((ext_vector_type(4)));
typedef float f32x16 __attribute__((ext_vector_type(16)));
typedef short bf16x8 __attribute__((ext_vector_type(8)));
typedef short s16x4 __attribute__((ext_vector_type(4)));
constexpr int NWAVES = 8, NTHR = 512;
constexpr int DM = 2048, BATCH = 8, SEQ = 2048, M = BATCH * SEQ, INC = 6144, DFF = 8192, NCH = 1024;
constexpr float ALPHA = 1.189207115002721f;
constexpr float LN_EPS = 1e-5f, LOG2E = 1.4426950408889634f, QSCALE = 0.125f * LOG2E;
constexpr size_t MiB = 1u << 20;
constexpr size_t WS_WIN = 1 * MiB, WS_WOUT = 25 * MiB, WS_WFF1 = 33 * MiB, WS_WFF2 = 65 * MiB;
constexpr size_t WS_XB = 97 * MiB;
constexpr size_t WS_PROJ = 161 * MiB;
constexpr size_t WS_X1B = 353 * MiB;
constexpr size_t WS_YT = 353 * MiB, WS_VGT = 417 * MiB, WS_X1T = 449 * MiB, WS_FILT = 481 * MiB;
constexpr size_t WS_H = 97 * MiB;
constexpr size_t WS_END = 489 * MiB;
constexpr int LDS_BYTES = 131072;

__device__ __forceinline__ unsigned pk2(float lo, float hi) { return pg8::cvt_pk_bf16(lo, hi); }
__device__ __forceinline__ unsigned short f2bf(float f) { unsigned u = __builtin_bit_cast(unsigned, f); return (unsigned short)((u + 0x7fffu + ((u >> 16) & 1u)) >> 16); }
__device__ __forceinline__ float bflo(unsigned w) { return __uint_as_float(w << 16); }
__device__ __forceinline__ float bfhi(unsigned w) { return __uint_as_float(w & 0xffff0000u); }
__device__ __forceinline__ float wave_sum(float v) {
#pragma unroll
    for (int o = 1; o < 64; o <<= 1) v += __shfl_xor(v, o);
    return v;
}
__device__ __forceinline__ float half_swap_max(float v) { auto rr = __builtin_amdgcn_permlane32_swap(__float_as_uint(v), __float_as_uint(v), false, false); return fmaxf(__uint_as_float(rr[0]), __uint_as_float(rr[1])); }
__device__ __forceinline__ float half_swap_sum(float v) { auto rr = __builtin_amdgcn_permlane32_swap(__float_as_uint(v), __float_as_uint(v), false, false); return __uint_as_float(rr[0]) + __uint_as_float(rr[1]); }

struct Frame {
    LAS unsigned char* lds;
    int tid, lane, wave, vcu, G;
    const float *x, *w_in, *lq1, *lk1, *lq2, *lk2, *subg, *conv_w, *conv_b, *fw1, *fb1, *ffreq, *fw2, *fb2, *fw3, *hskip, *hgain, *w_out, *ln1g, *ln1b, *w_ff1, *w_ff2, *ln2g, *ln2b;
    float* out;
    bf16 *WinT, *WoutT, *Wff1T, *Wff2T, *xb, *mix, *proj, *x1b, *yT, *vgT, *x1T, *filt, *hbuf;
};

__device__ __forceinline__ void p0_transpose_item(const float* W, int K, int N, bf16* WT, LAS float* scr, int item, int lane) {
    const int nblk = N / 32, kb = item / nblk, nb = item % nblk, k0 = 64 * kb, n0 = 32 * nb;
#pragma unroll 8
    for (int i = 0; i < 32; ++i) { const int kk = 2 * i + (lane >> 5); scr[kk * 33 + (lane & 31)] = W[(size_t)(k0 + kk) * N + n0 + (lane & 31)]; }
    asm volatile("s_waitcnt lgkmcnt(0)" ::: "memory");
    const int c = lane & 7;
#pragma unroll
    for (int j = 0; j < 4; ++j) { const int n = (lane >> 3) + 8 * j; const LAS float* s = scr + (8 * c) * 33 + n;
        u32x4 o; o.x = pk2(s[0 * 33], s[1 * 33]); o.y = pk2(s[2 * 33], s[3 * 33]); o.z = pk2(s[4 * 33], s[5 * 33]); o.w = pk2(s[6 * 33], s[7 * 33]);
        *(u32x4*)(WT + (size_t)(n0 + n) * K + k0 + 8 * c) = o; }
    asm volatile("s_waitcnt lgkmcnt(0)" ::: "memory");
}
__device__ __forceinline__ void filter_item(Frame& F, int it) {
    LAS float* zs = (LAS float*)F.lds; LAS float* h1s = zs + 16 * 33; LAS float* h2s = h1s + 16 * 64;
    const int tid = F.tid, l0 = it * 16;
    for (int idx = tid; idx < 16 * 33; idx += NTHR) { const int r = idx / 33, e = idx - r * 33, l = l0 + r; float val;
        if (e == 0) val = (float)l / 2047.0f;
        else { const int j = (e - 1) & 15; const float f = 1e-4f + (float)j * ((15.0f - 1e-4f) / 15.0f); const float w = (6.283185307179586f * (float)l) / 2048.0f; const float a = f * w; val = (e <= 16) ? __cosf(a) : -__sinf(a); }
        zs[idx] = val; }
    __syncthreads();
    for (int idx = tid; idx < 1024; idx += NTHR) { const int r = idx >> 6, o = idx & 63; float a = F.fb1[o];
        for (int e = 0; e < 33; ++e) a += zs[r * 33 + e] * F.fw1[e * 64 + o];
        h1s[idx] = __sinf(F.ffreq[o] * a); }
    __syncthreads();
    for (int idx = tid; idx < 1024; idx += NTHR) { const int r = idx >> 6, o = idx & 63; float a = F.fb2[o];
        for (int e = 0; e < 64; ++e) a += h1s[r * 64 + e] * F.fw2[e * 64 + o];
        h2s[idx] = __sinf(F.ffreq[o] * a); }
    __syncthreads();
    const int n0 = tid * 4;
    f32x4 acc[16];
#pragma unroll
    for (int r = 0; r < 16; ++r) acc[r] = (f32x4){0.f, 0.f, 0.f, 0.f};
    for (int k = 0; k < 64; k += 4) {
        const f32x4 w0 = *(const f32x4*)(F.fw3 + (size_t)(k + 0) * 2048 + n0), w1 = *(const f32x4*)(F.fw3 + (size_t)(k + 1) * 2048 + n0),
                    w2 = *(const f32x4*)(F.fw3 + (size_t)(k + 2) * 2048 + n0), w3 = *(const f32x4*)(F.fw3 + (size_t)(k + 3) * 2048 + n0);
#pragma unroll
        for (int r = 0; r < 16; ++r) { const f32x4 hv = *(const LAS f32x4*)(h2s + r * 64 + k); acc[r] += w0 * hv.x + w1 * hv.y + w2 * hv.z + w3 * hv.w; }
    }
    const int ch0 = n0 & 1023; const bool fwd = n0 < 1024;
    const float DMIN = -3.0701134573253945f, DMAX = -15.350567286626972f;
#pragma unroll
    for (int e = 0; e < 4; ++e) { const int ch = ch0 + e; const float ad = fabsf(DMIN + (float)ch * ((DMAX - DMIN) / 1023.0f)); bf16* dst = F.filt + (size_t)ch * 4096;
#pragma unroll
        for (int r = 0; r < 16; ++r) { const int l = l0 + r; const float tl = (float)l / 2047.0f; const float val = acc[r][e] * __expf(-tl * ad);
            if (fwd) dst[2048 - l] = f2bf(val); else if (l >= 1) dst[2048 + l] = f2bf(val); }
        if (it == 0 && fwd) dst[0] = 0; }
    __syncthreads();
}
__device__ __forceinline__ void h1_item(Frame& F, int item) {
    const int cblk = item & 15, sblk = (item >> 4) & 31, b = item >> 9;
    const int tid = F.tid, s_l = tid >> 3, cg8 = tid & 7;
    const int s = sblk * 64 + s_l, c = cblk * 64 + cg8 * 8;
    const bf16* row = F.proj + ((size_t)(b * SEQ + s)) * INC + 3072 + c;
    float z[3][8];
#pragma unroll
    for (int a = 0; a < 3; ++a) { const bf16* p = row + a * 1024;
        u32x4 um = (u32x4){0u, 0u, 0u, 0u}, up = (u32x4){0u, 0u, 0u, 0u}; const u32x4 u0 = *(const u32x4*)p;
        if (s > 0) um = *(const u32x4*)(p - INC);
        if (s < SEQ - 1) up = *(const u32x4*)(p + INC);
        const float* cw = F.conv_w + a * 1024 + c; const float* cb = F.conv_b + a * 1024 + c;
#pragma unroll
        for (int e2 = 0; e2 < 4; ++e2) {
            const float m0 = bflo(um[e2]), m1 = bfhi(um[e2]), c0 = bflo(u0[e2]), c1 = bfhi(u0[e2]), p0 = bflo(up[e2]), p1 = bfhi(up[e2]);
            z[a][2 * e2]     = cb[2 * e2]     + m0 * cw[2 * e2]     + c0 * cw[3072 + 2 * e2]     + p0 * cw[6144 + 2 * e2];
            z[a][2 * e2 + 1] = cb[2 * e2 + 1] + m1 * cw[2 * e2 + 1] + c1 * cw[3072 + 2 * e2 + 1] + p1 * cw[6144 + 2 * e2 + 1]; } }
    LAS unsigned short* tv = (LAS unsigned short*)F.lds; LAS unsigned short* tx = tv + 64 * 66;
#pragma unroll
    for (int e = 0; e < 8; ++e) { tv[(cg8 * 8 + e) * 66 + s_l] = f2bf(z[2][e] * z[1][e]); tx[(cg8 * 8 + e) * 66 + s_l] = f2bf(z[0][e]); }
    __syncthreads();
    { const int c_l = tid >> 3, chunk = tid & 7;
      const LAS unsigned* pv = (const LAS unsigned*)(F.lds + c_l * 132 + chunk * 16); const LAS unsigned* px = (const LAS unsigned*)(F.lds + 64 * 132 + c_l * 132 + chunk * 16);
      u32x4 ov, ox; ov.x = pv[0]; ov.y = pv[1]; ov.z = pv[2]; ov.w = pv[3]; ox.x = px[0]; ox.y = px[1]; ox.z = px[2]; ox.w = px[3];
      const size_t go = ((size_t)((cblk * 64 + c_l) * 8 + b)) * 2048 + sblk * 64 + chunk * 8;
      *(u32x4*)(F.vgT + go) = ov; *(u32x4*)(F.x1T + go) = ox; }
    __syncthreads();
}
namespace att {
constexpr int KOFF = 0, VOFF = 32768, QOFF = 65536;
__device__ __forceinline__ int toff(int row, int ch) { return 256 * row + 16 * (ch ^ (((row & 3) << 2) | ((row >> 2) & 3))); }
#define MFMA32(a, b, c) __builtin_amdgcn_mfma_f32_32x32x16_bf16((a), (b), (c), 0, 0, 0)
__device__ __forceinline__ s16x4 vtr(const LAS unsigned char* p) { return __builtin_bit_cast(s16x4, __builtin_amdgcn_ds_read_tr16_b64_v4i16((LAS s16x4*)p)); }

__device__ __forceinline__ void attn_unit(LAS unsigned char* lds, const bf16* proj, bf16* mix, int b, int h, int qb, float lam, const float* subg) {
    const int tid = threadIdx.x, lane = tid & 63, r32 = lane & 31, hi = lane >> 5;
    const int wid = __builtin_amdgcn_readfirstlane(tid >> 6);
    const int c = wid & 1, qi = wid >> 1;
    const size_t rowbase = (size_t)b * SEQ;
    const int qpos = qb * 128 + qi * 32 + r32;
    bf16x8 qf[4];
    { const bf16* qg = proj + (rowbase + qpos) * INC + h * 128 + c * 64 + hi * 8;
#pragma unroll
      for (int d0 = 0; d0 < 4; ++d0) qf[d0] = *(const bf16x8*)(qg + d0 * 16); }
    const bf16* kvg = proj + rowbase * INC + 1024 + h * 128;
    size_t goff[2];
#pragma unroll
    for (int j = 0; j < 2; ++j) { const int row = 8 * wid + 4 * j + (lane >> 4); const int sw = ((lane >> 4) << 2) | ((2 * wid + j) & 3); goff[j] = (size_t)row * INC + 8 * ((lane & 15) ^ sw); }
#define ATT_STAGE(t_, buf_) do { const bf16* kt_ = kvg + (size_t)(t_) * 64 * INC; _Pragma("unroll") for (int j_ = 0; j_ < 2; ++j_) { \
        __builtin_amdgcn_global_load_lds((const unsigned*)(kt_ + goff[j_]), (LAS unsigned*)(lds + KOFF + (buf_) * 16384 + 256 * (8 * wid + 4 * j_)), 16, 0, 0); \
        __builtin_amdgcn_global_load_lds((const unsigned*)(kt_ + goff[j_] + 1024), (LAS unsigned*)(lds + VOFF + (buf_) * 16384 + 256 * (8 * wid + 4 * j_)), 16, 0, 0); } } while (0)
    ATT_STAGE(0, 0);
    asm volatile("s_waitcnt vmcnt(0)" ::: "memory");
    __syncthreads();
    const float sl2 = exp2f(-(float)(h + 1)) * LOG2E;
    const int swr = ((r32 & 3) << 2) | ((r32 >> 2) & 3);
    const LAS unsigned char* kbase = lds + KOFF + 256 * r32;
    const int i16 = lane & 15, g1 = (lane >> 4) & 1;
    int vaddr[4][2];
#pragma unroll
    for (int db = 0; db < 4; ++db)
#pragma unroll
        for (int sec = 0; sec < 2; ++sec) { const int swv = ((i16 >> 2) << 2) | (hi + 2 * sec); const int ch = 4 * db + 2 * g1 + ((i16 & 3) >> 1);
            vaddr[db][sec] = VOFF + 256 * (4 * hi + (i16 >> 2) + 8 * sec) + 16 * (ch ^ swv) + 8 * (i16 & 1); }
    f32x16 o[4];
#pragma unroll
    for (int db = 0; db < 4; ++db)
#pragma unroll
        for (int i = 0; i < 16; ++i) o[db][i] = 0.f;
    float mref = 0.f, lsum = 0.f;
    for (int t = 0; t < SEQ / 64; ++t) {
        const int buf = t & 1; const bool more = (t + 1 < SEQ / 64);
        if (more) ATT_STAGE(t + 1, buf ^ 1);
        f32x16 p[2];
#pragma unroll
        for (int kh = 0; kh < 2; ++kh) {
            const float basef = (float)(qpos - 64 * t - 32 * kh - 4 * hi);
            f32x16 acc;
#pragma unroll
            for (int i = 0; i < 16; ++i) { const float ti = basef - (float)((i & 3) + 8 * (i >> 2)); acc[i] = fmaf(-sl2, fabsf(ti), -mref); }
#pragma unroll
            for (int d0 = 0; d0 < 4; ++d0) { const int ch = c * 8 + d0 * 2 + hi;
                const bf16x8 kf = *(const LAS bf16x8*)(kbase + buf * 16384 + kh * 8192 + 16 * (ch ^ swr));
                acc = MFMA32(kf, qf[d0], acc); }
            p[kh] = acc;
        }
        float rm = fmaxf(p[0][0], p[1][0]);
#pragma unroll
        for (int i = 1; i < 16; ++i) rm = fmaxf(rm, fmaxf(p[0][i], p[1][i]));
        rm = half_swap_max(rm);
        if (t == 0 || __any(rm > 8.0f)) {
            const float delta = (t == 0) ? rm : fmaxf(rm, 0.f);
            mref += delta;
#pragma unroll
            for (int i = 0; i < 16; ++i) { p[0][i] -= delta; p[1][i] -= delta; }
            if (t != 0) { const float f = __builtin_amdgcn_exp2f(-delta); lsum *= f;
#pragma unroll
                for (int db = 0; db < 4; ++db) o[db] = o[db] * f; }
        }
        float sum = 0.f;
#pragma unroll
        for (int i = 0; i < 16; ++i) { p[0][i] = __builtin_amdgcn_exp2f(p[0][i]); p[1][i] = __builtin_amdgcn_exp2f(p[1][i]); sum += p[0][i] + p[1][i]; }
        lsum += sum;
        bf16x8 pfr[4];
#pragma unroll
        for (int kh = 0; kh < 2; ++kh)
#pragma unroll
            for (int sp = 0; sp < 2; ++sp) { u32x4 w; w.x = pk2(p[kh][8 * sp + 0], p[kh][8 * sp + 1]); w.y = pk2(p[kh][8 * sp + 2], p[kh][8 * sp + 3]); w.z = pk2(p[kh][8 * sp + 4], p[kh][8 * sp + 5]); w.w = pk2(p[kh][8 * sp + 6], p[kh][8 * sp + 7]);
                pfr[2 * kh + sp] = __builtin_bit_cast(bf16x8, w); }
#pragma unroll
        for (int db = 0; db < 4; ++db)
#pragma unroll
            for (int s = 0; s < 4; ++s) { const LAS unsigned char* vb = lds + buf * 16384 + 4096 * s;
                const s16x4 lo = vtr(vb + vaddr[db][0]), hi4 = vtr(vb + vaddr[db][1]);
                const bf16x8 vf = (bf16x8){lo[0], lo[1], lo[2], lo[3], hi4[0], hi4[1], hi4[2], hi4[3]};
                o[db] = MFMA32(vf, pfr[s], o[db]); }
        asm volatile("s_waitcnt vmcnt(0)" ::: "memory");
        __syncthreads();
    }
    const float lt = half_swap_sum(lsum);
    LAS float* xch = (LAS float*)(lds + QOFF + qi * 16384) + lane;
    if (c == 1) { const float inv = lam / lt;
#pragma unroll
        for (int db = 0; db < 4; ++db)
#pragma unroll
            for (int i = 0; i < 16; ++i) xch[(db * 16 + i) * 64] = o[db][i] * inv; }
    __syncthreads();
    if (c == 0) {
        const float inv = 1.0f / lt; float ss = 0.f;
#pragma unroll
        for (int db = 0; db < 4; ++db)
#pragma unroll
            for (int i = 0; i < 16; ++i) { const float v = o[db][i] * inv - xch[(db * 16 + i) * 64]; o[db][i] = v; ss += v * v; }
        ss = half_swap_sum(ss);
        const float rstd = (1.0f / sqrtf(ss * (1.0f / 128.0f) + LN_EPS)) * 0.8f;
        bf16* orow = mix + (rowbase + qpos) * DM + h * 128;
#pragma unroll
        for (int db = 0; db < 4; ++db)
#pragma unroll
            for (int g = 0; g < 4; ++g) { const int d = 32 * db + 8 * g + 4 * hi; const f32x4 gg = *(const f32x4*)(subg + d);
                u32x2 w; w.x = pk2(o[db][4 * g] * rstd * gg.x, o[db][4 * g + 1] * rstd * gg.y); w.y = pk2(o[db][4 * g + 2] * rstd * gg.z, o[db][4 * g + 3] * rstd * gg.w);
                *(u32x2*)(orow + d) = w; }
    }
    __syncthreads();
}
#undef ATT_STAGE
}

namespace hy {
constexpr int CPS = 8224, VGO = 8 * CPS, VGS = 4112, RSTG = VGO + 8 * VGS;
#define MFMA16(a, b, c) __builtin_amdgcn_mfma_f32_16x16x32_bf16((a), (b), (c), 0, 0, 0)
__device__ __forceinline__ void conv_unit(LAS unsigned char* lds, int c, const bf16* filt, const bf16* vgT, const bf16* x1T, bf16* yT, const float* dskip) {
    const int tid = threadIdx.x, lane = tid & 63; const int wid = __builtin_amdgcn_readfirstlane(tid >> 6);
    *(LAS u32x4*)(lds + RSTG + tid * 16) = *(const u32x4*)(filt + (size_t)c * 4096 + tid * 8);
#pragma unroll
    for (int k = 0; k < 4; ++k) { const int id = tid + 512 * k, bb = id >> 8, ch = id & 255; *(LAS u32x4*)(lds + VGO + bb * VGS + ch * 16) = *(const u32x4*)(vgT + ((size_t)(c * 8 + bb)) * 2048 + ch * 8); }
    __syncthreads();
    { const LAS unsigned short* R = (const LAS unsigned short*)(lds + RSTG);
      for (int id = tid; id < 8 * 513; id += NTHR) { const int sh = id / 513, m = id - sh * 513; const int n0 = 8 * m - sh; unsigned w[4];
#pragma unroll
          for (int jj = 0; jj < 4; ++jj) { const int na = n0 + 2 * jj, nb = na + 1; const unsigned lo = (na >= 0 && na < 4096) ? (unsigned)R[na] : 0u; const unsigned hi = (nb >= 0 && nb < 4096) ? (unsigned)R[nb] : 0u; w[jj] = lo | (hi << 16); }
          *(LAS u32x4*)(lds + sh * CPS + m * 16) = (u32x4){w[0], w[1], w[2], w[3]}; } }
    __syncthreads();
    const int i = lane & 15, kq = lane >> 4;
    f32x4 acc[16];
#pragma unroll
    for (int a = 0; a < 16; ++a) acc[a] = (f32x4){0.f, 0.f, 0.f, 0.f};
    const LAS unsigned char* abase = lds + (i & 7) * CPS + 16 * (256 - 32 * wid - (i >> 3) + kq - 30);
    const LAS unsigned char* bbase = lds + VGO + (i & 7) * VGS + 16 * kq;
    for (int sc = 0; sc < 4; ++sc) {
        bf16x8 bfr[16];
#pragma unroll
        for (int ci = 0; ci < 16; ++ci) bfr[ci] = *(const LAS bf16x8*)(bbase + 64 * (16 * sc + ci));
        const LAS unsigned char* ab = abase + 1024 * sc;
#pragma unroll
        for (int vv = 0; vv < 46; ++vv) {
            const bf16x8 af = *(const LAS bf16x8*)(ab + 32 * vv);
#pragma unroll
            for (int ci = 0; ci < 16; ++ci) { const int ai = 2 * ci - (vv - 15); if (ai >= 0 && ai < 16) acc[ai] = MFMA16(af, bfr[ci], acc[ai]); }
        }
    }
    if (i < 8) {
        const float dsk = dskip[c];
#pragma unroll
        for (int ai = 0; ai < 16; ++ai) { const int t = 16 * (16 * wid + ai) + 4 * kq;
            const u32x2 vg = *(const LAS u32x2*)(lds + VGO + i * VGS + 2 * t); const u32x2 x1 = *(const u32x2*)(x1T + ((size_t)(c * 8 + i)) * 2048 + t);
            const float y0 = (acc[ai][0] + bflo(vg.x) * dsk) * bflo(x1.x), y1 = (acc[ai][1] + bfhi(vg.x) * dsk) * bfhi(x1.x), y2 = (acc[ai][2] + bflo(vg.y) * dsk) * bflo(x1.y), y3 = (acc[ai][3] + bfhi(vg.y) * dsk) * bfhi(x1.y);
            u32x2 w; w.x = pk2(y0, y1); w.y = pk2(y2, y3); *(u32x2*)(yT + ((size_t)(c * 8 + i)) * 2048 + t) = w; }
    }
    __syncthreads();
}
}

__device__ __forceinline__ void h3_item(Frame& F, int item) {
    constexpr int RS = 2064;
    const int b = item >> 6, t0 = (item & 63) * 32, tid = F.tid;
#pragma unroll
    for (int k = 0; k < 8; ++k) { const int id = tid + 512 * k, c = id >> 2, chunk = id & 3;
        const u32x4 v = *(const u32x4*)(F.yT + ((size_t)(c * 8 + b)) * 2048 + t0 + chunk * 8);
        LAS unsigned char* base = F.lds + (chunk * 8) * RS + c * 2;
        *(LAS unsigned short*)(base + 0 * RS) = (unsigned short)(v.x & 0xffffu); *(LAS unsigned short*)(base + 1 * RS) = (unsigned short)(v.x >> 16);
        *(LAS unsigned short*)(base + 2 * RS) = (unsigned short)(v.y & 0xffffu); *(LAS unsigned short*)(base + 3 * RS) = (unsigned short)(v.y >> 16);
        *(LAS unsigned short*)(base + 4 * RS) = (unsigned short)(v.z & 0xffffu); *(LAS unsigned short*)(base + 5 * RS) = (unsigned short)(v.z >> 16);
        *(LAS unsigned short*)(base + 6 * RS) = (unsigned short)(v.w & 0xffffu); *(LAS unsigned short*)(base + 7 * RS) = (unsigned short)(v.w >> 16); }
    __syncthreads();
    const int t_l = tid >> 4, cgp = tid & 15;
    u32x4 d[8]; float ss = 0.f;
#pragma unroll
    for (int k = 0; k < 8; ++k) { d[k] = *(const LAS u32x4*)(F.lds + t_l * RS + (16 * k + cgp) * 16);
#pragma unroll
        for (int e = 0; e < 4; ++e) { const float a = bflo(d[k][e]), bq = bfhi(d[k][e]); ss += a * a + bq * bq; } }
    ss += __shfl_xor(ss, 1); ss += __shfl_xor(ss, 2); ss += __shfl_xor(ss, 4); ss += __shfl_xor(ss, 8);
    const float rstd = 1.0f / sqrtf(ss * (1.0f / 1024.0f) + LN_EPS);
    bf16* orow = F.mix + ((size_t)(b * SEQ + t0 + t_l)) * DM + 1024;
#pragma unroll
    for (int k = 0; k < 8; ++k) { const int c0 = (16 * k + cgp) * 8; const f32x4 g0 = *(const f32x4*)(F.hgain + c0), g1 = *(const f32x4*)(F.hgain + c0 + 4);
        u32x4 w; w.x = pk2(bflo(d[k].x) * rstd * g0.x, bfhi(d[k].x) * rstd * g0.y); w.y = pk2(bflo(d[k].y) * rstd * g0.z, bfhi(d[k].y) * rstd * g0.w);
        w.z = pk2(bflo(d[k].z) * rstd * g1.x, bfhi(d[k].z) * rstd * g1.y); w.w = pk2(bflo(d[k].w) * rstd * g1.z, bfhi(d[k].w) * rstd * g1.w);
        *(u32x4*)(orow + c0) = w; }
    __syncthreads();
}
__device__ __forceinline__ void ln_rows(Frame& F, float* buf, const float* g, const float* bt, bf16* ob) {
    const int gw = blockIdx.x * NWAVES + F.wave, NGW = F.G * NWAVES;
    for (int m = gw; m < M; m += NGW) {
        f32x4* row = (f32x4*)(buf + (size_t)m * DM) + F.lane;
        f32x4 v[8]; float s = 0.f;
#pragma unroll
        for (int j = 0; j < 8; ++j) { v[j] = row[64 * j]; s += (v[j].x + v[j].y) + (v[j].z + v[j].w); }
        const float mean = wave_sum(s) * (1.0f / DM); float s2 = 0.f;
#pragma unroll
        for (int j = 0; j < 8; ++j) { v[j] = v[j] - mean; s2 += (v[j].x * v[j].x + v[j].y * v[j].y) + (v[j].z * v[j].z + v[j].w * v[j].w); }
        const float rstd = 1.0f / sqrtf(wave_sum(s2) * (1.0f / DM) + LN_EPS);
#pragma unroll
        for (int j = 0; j < 8; ++j) { const f32x4 gg = ((const f32x4*)g)[F.lane + 64 * j], bb = ((const f32x4*)bt)[F.lane + 64 * j]; const f32x4 y = v[j] * rstd * gg + bb; row[64 * j] = y;
            if (ob) { u32x2 w; w.x = pk2(y.x, y.y); w.y = pk2(y.z, y.w); *((u32x2*)(ob + (size_t)m * DM) + F.lane + 64 * j) = w; } }
    }
}
struct Args { const float* in[24]; float* out; unsigned char* ws; int ph_lo, ph_hi; };
constexpr int N_PHASES = 10;
__global__ void __launch_bounds__(NTHR, 2) hymba_fwd(Args args) {
    extern __shared__ __attribute__((aligned(16))) unsigned char lds_raw[];
    Frame F;
    F.lds = (LAS unsigned char*)lds_raw;
    F.tid = threadIdx.x; F.lane = F.tid & 63; F.wave = __builtin_amdgcn_readfirstlane(F.tid >> 6);
    F.G = gridDim.x; { const int bx = blockIdx.x; F.vcu = (F.G % 8 == 0) ? (bx % 8) * (F.G / 8) + bx / 8 : bx; }
    unsigned char* ws = args.ws;
    F.x = args.in[0]; F.w_in = args.in[1]; F.lq1 = args.in[2]; F.lk1 = args.in[3]; F.lq2 = args.in[4]; F.lk2 = args.in[5]; F.subg = args.in[6]; F.conv_w = args.in[7]; F.conv_b = args.in[8];
    F.fw1 = args.in[9]; F.fb1 = args.in[10]; F.ffreq = args.in[11]; F.fw2 = args.in[12]; F.fb2 = args.in[13]; F.fw3 = args.in[14]; F.hskip = args.in[15]; F.hgain = args.in[16];
    F.w_out = args.in[17]; F.ln1g = args.in[18]; F.ln1b = args.in[19]; F.w_ff1 = args.in[20]; F.w_ff2 = args.in[21]; F.ln2g = args.in[22]; F.ln2b = args.in[23]; F.out = args.out;
    F.WinT = (bf16*)(ws + WS_WIN); F.WoutT = (bf16*)(ws + WS_WOUT); F.Wff1T = (bf16*)(ws + WS_WFF1); F.Wff2T = (bf16*)(ws + WS_WFF2);
    F.xb = (bf16*)(ws + WS_XB); F.mix = (bf16*)(ws + WS_XB); F.proj = (bf16*)(ws + WS_PROJ); F.x1b = (bf16*)(ws + WS_X1B); F.yT = (bf16*)(ws + WS_YT);
    F.vgT = (bf16*)(ws + WS_VGT); F.x1T = (bf16*)(ws + WS_X1T); F.filt = (bf16*)(ws + WS_FILT); F.hbuf = (bf16*)(ws + WS_H);
    const int lo = args.ph_lo, hi = args.ph_hi;
#ifndef PHMASK
#define PHMASK 0x3ff
#endif
#define IN(k) ((((PHMASK) >> (k)) & 1) && lo <= (k) && (k) < hi)
#ifndef REPMASK
#define REPMASK 0
#endif
#define REP(k) for (int rep_ = 0; rep_ < ((((REPMASK) >> (k)) & 1) ? 2 : 1); ++rep_)
#define SEAM(k) do { if (IN(k) && IN((k) + 1)) cg::this_grid().sync(); } while (0)

    if (IN(0)) REP(0) {
        { LAS float* scr = (LAS float*)(F.lds + F.wave * 8704);
          const int gw = F.vcu * NWAVES + F.wave, NGW = F.G * NWAVES;
          constexpr int I_IN = (DM / 64) * (INC / 32), I_OUT = (DM / 64) * (DM / 32), I_F1 = (DM / 64) * (DFF / 32), I_F2 = (DFF / 64) * (DM / 32);
          for (int it = gw; it < I_IN + I_OUT + I_F1 + I_F2; it += NGW) { int r = it;
              if (r < I_IN) { p0_transpose_item(F.w_in, DM, INC, F.WinT, scr, r, F.lane); continue; } r -= I_IN;
              if (r < I_OUT) { p0_transpose_item(F.w_out, DM, DM, F.WoutT, scr, r, F.lane); continue; } r -= I_OUT;
              if (r < I_F1) { p0_transpose_item(F.w_ff1, DM, DFF, F.Wff1T, scr, r, F.lane); continue; } r -= I_F1;
              p0_transpose_item(F.w_ff2, DFF, DM, F.Wff2T, scr, r, F.lane); } }
        __syncthreads();
        for (int it = blockIdx.x; it < SEQ / 16; it += F.G) filter_item(F, it);
        { const size_t nchunk = (size_t)M * DM / 8; const f32x4* x4 = (const f32x4*)F.x; u32x4* xo = (u32x4*)F.xb;
          for (size_t ch = (size_t)blockIdx.x * NTHR + F.tid; ch < nchunk; ch += (size_t)F.G * NTHR) { const f32x4 a = x4[2 * ch], b = x4[2 * ch + 1]; u32x4 o; o.x = pk2(a.x, a.y); o.y = pk2(a.z, a.w); o.z = pk2(b.x, b.y); o.w = pk2(b.z, b.w); xo[ch] = o; } }
    }
    SEAM(0);
    if (IN(1)) REP(1) {
        pg8::Gemm g{F.xb, F.WinT, M, INC, DM}; pg8::StaticOrder S; S.init(M, INC, F.G, (int)blockIdx.x);
        pg8::EpiBf16<0> E{F.proj, INC, 1024, QSCALE};
        pg8::gemm_phase<pg8::EpiBf16<0>, pg8::StaticOrder, true, true>(F.lds, g, S, E);
    }
    SEAM(1);
    if (IN(2)) REP(2) { for (int it = blockIdx.x; it < 4096; it += F.G) h1_item(F, it); }
    SEAM(2);
    if (IN(3)) REP(3) {
        float sa = F.lq1[F.lane] * F.lk1[F.lane], sb = F.lq2[F.lane] * F.lk2[F.lane]; sa = wave_sum(sa); sb = wave_sum(sb);
        const float lam = __expf(sa) - __expf(sb) + 0.2f;
#ifndef NO_ATT
        for (int u = F.vcu; u < 1024; u += F.G) att::attn_unit(F.lds, F.proj, F.mix, u >> 7, (u >> 4) & 7, u & 15, lam, F.subg);
#endif
#ifndef NO_HY
        for (int c = F.vcu; c < NCH; c += F.G) hy::conv_unit(F.lds, c, F.filt, F.vgT, F.x1T, F.yT, F.hskip);
#endif
    }
    SEAM(3);
    if (IN(4)) REP(4) { for (int it = blockIdx.x; it < 512; it += F.G) h3_item(F, it); }
    SEAM(4);
    if (IN(5)) REP(5) {
        pg8::Gemm g{F.mix, F.WoutT, M, DM, DM}; pg8::StaticOrder S; S.init(M, DM, F.G, (int)blockIdx.x);
        pg8::EpiResF32 E{F.x, F.out, DM, ALPHA};
        pg8::gemm_phase<pg8::EpiResF32, pg8::StaticOrder, true, true>(F.lds, g, S, E);
    }
    SEAM(5);
    if (IN(6)) ln_rows(F, F.out, F.ln1g, F.ln1b, F.x1b);
    SEAM(6);
    if (IN(7)) REP(7) {
        pg8::Gemm g{F.x1b, F.Wff1T, M, DFF, DM}; pg8::StaticOrder S; S.init(M, DFF, F.G, (int)blockIdx.x);
        pg8::EpiBf16<2> E{F.hbuf, DFF, 0, 1.f};
        pg8::gemm_phase<pg8::EpiBf16<2>, pg8::StaticOrder, true, true>(F.lds, g, S, E);
    }
    SEAM(7);
    if (IN(8)) {
        pg8::Gemm g{F.hbuf, F.Wff2T, M, DM, DFF}; pg8::StaticOrder S; S.init(M, DM, F.G, (int)blockIdx.x);
        pg8::EpiResF32 E{F.out, F.out, DM, ALPHA};
        pg8::gemm_phase<pg8::EpiResF32, pg8::StaticOrder, true, true>(F.lds, g, S, E);
    }
    SEAM(8);
    if (IN(9)) ln_rows(F, F.out, F.ln2g, F.ln2b, nullptr);
#undef IN
#undef SEAM
}

#ifndef MK_N_LAUNCHES
#define MK_N_LAUNCHES 1
#endif
extern "C" void kernel_launch(void* const* d_in, const int* in_sizes, int n_in, void* d_out, int out_size, void* d_ws, size_t ws_size, hipStream_t stream) {
    static int grid = 0;
    if (grid == 0) {
        if (n_in != 24 || in_sizes[0] != M * DM || out_size != M * DM || ws_size < WS_END) { fprintf(stderr, "kernel_launch: unexpected problem shape (n_in %d, in0 %d, out %d, ws %zu); nothing launched\n", n_in, n_in > 0 ? in_sizes[0] : -1, out_size, ws_size); grid = -1; return; }
        int dev = 0, cus = 0, per_cu = 0;
        if (hipGetDevice(&dev) != hipSuccess || hipDeviceGetAttribute(&cus, hipDeviceAttributeMultiprocessorCount, dev) != hipSuccess) { grid = -1; return; }
        if (hipFuncSetAttribute((const void*)hymba_fwd, hipFuncAttributeMaxDynamicSharedMemorySize, LDS_BYTES) != hipSuccess) { fprintf(stderr, "kernel_launch: hipFuncSetAttribute failed\n"); grid = -1; return; }
        if (hipOccupancyMaxActiveBlocksPerMultiprocessor(&per_cu, (const void*)hymba_fwd, NTHR, LDS_BYTES) != hipSuccess || per_cu < 1) { fprintf(stderr, "kernel_launch: occupancy query says %d blocks per CU\n", per_cu); per_cu = 1; }
        (void)hipGetLastError();
        grid = cus * per_cu;
    }
    if (grid < 0) return;
    Args a{};
    for (int i = 0; i < 24; ++i) a.in[i] = (const float*)d_in[i];
    a.out = (float*)d_out; a.ws = (unsigned char*)d_ws;
#if MK_N_LAUNCHES == 1
    a.ph_lo = 0; a.ph_hi = N_PHASES;
    void* kargs[] = {&a};
    const hipError_t e = hipLaunchCooperativeKernel((const void*)hymba_fwd, dim3(grid), dim3(NTHR), kargs, LDS_BYTES, stream);
    if (e != hipSuccess) fprintf(stderr, "kernel_launch: cooperative launch failed: %s (grid %d)\n", hipGetErrorString(e), grid);
#else
    for (int p = 0; p < N_PHASES; ++p) { a.ph_lo = p; a.ph_hi = p + 1; hipLaunchKernelGGL(hymba_fwd, dim3(grid), dim3(NTHR), LDS_BYTES, stream, a); }
#endif
}
```

```cpp
#include <hip/hip_runtime.h>
#include <hip/hip_cooperative_groups.h>
#include <cstdio>
#include <cstdint>
namespace cg = cooperative_groups;
namespace pg8 {
#define PG8_LAS __attribute__((address_space(3)))
typedef unsigned short bf16_t;
typedef short bf16x8 __attribute__((ext_vector_type(8)));
typedef float f32x4 __attribute__((ext_vector_type(4)));
typedef unsigned u32x4 __attribute__((ext_vector_type(4)));
constexpr int BM = 256, BK = 64, HALF = 128, HTB = HALF * BK * 2  , STAGE_BYTES = 8 * HTB, NXCD = 8, WGM = 8;

__host__ __device__ __forceinline__ int lds_byte(int r, int c) { const int st = (r >> 4) * 2 + (c >> 5), rr = r & 15, cc = c & 31, ob = rr * 64 + cc * 2; return st * 1024 + (ob ^ (((ob >> 9) & 1) << 5)); }
__host__ __device__ __forceinline__ void stage_rc(int b, int& R, int& C) { const int st = b / 1024, sb = b % 1024, swz = sb ^ (((sb >> 9) & 1) << 5); R = (st >> 1) * 16 + swz / 64; C = (st & 1) * 32 + (swz % 64) / 2; }
__host__ __device__ __forceinline__ int perm32(int rho) { const int n = rho >> 4, i = rho & 15; return 8 * (i >> 2) + 4 * n + (i & 3); }

struct Unit { int pm, pn; };
struct Gemm { const bf16_t* A; const bf16_t* Bt; int M, N, K; };

struct StaticOrder {
    int nM, nN, nwg, G, c;
    __host__ __device__ void init(int M, int N, int G_, int c_) { nM = M / BM; nN = N / BM; nwg = nM * nN; G = G_; c = c_; }
    __host__ __device__ bool next(int i, Unit& u) const {
        const long L = (long)i * G + c; if (L >= nwg) return false;
        int wgid = (int)L; { const int q = nwg / NXCD, r = nwg % NXCD, xcd = wgid % NXCD, off = wgid / NXCD; wgid = (xcd < r ? xcd * (q + 1) : r * (q + 1) + (xcd - r) * q) + off; }
        const int nig = WGM * nN, gid = wgid / nig, fm = gid * WGM, gsz = (nM - fm) < WGM ? (nM - fm) : WGM;
        u.pm = fm + ((wgid % nig) % gsz); u.pn = (wgid % nig) / gsz; return true;
    }
    __device__ __forceinline__ void a_ready(const Unit&) const {}
    __device__ __forceinline__ void done(const Unit&) const {}
};

__device__ __forceinline__ unsigned cvt_pk_bf16(float lo, float hi) { unsigned r; asm volatile("v_cvt_pk_bf16_f32 %0, %1, %2" : "=v"(r) : "v"(lo), "v"(hi)); return r; }
typedef float f32x2 __attribute__((ext_vector_type(2)));
template <int ACT> struct EpiBf16 {
    static constexpr bool PERM = true, AFTER_DRAIN = false;
    bf16_t* O; int ldc; int scale_cols; float scale0;
    __device__ __forceinline__ void operator()(const f32x4 (&acc)[2][2][4][2], const Unit& u, int wr, int wc, int fr, int fq) const {
        const int row0 = u.pm * BM + wr * 64 + fr; const int colt = u.pn * BM;
        const float sc = (colt < scale_cols) ? scale0 : 1.f;
        const int col0 = colt + wc * 32 + 8 * fq;
#pragma unroll
        for (int ai = 0; ai < 2; ++ai)
#pragma unroll
            for (int m = 0; m < 4; ++m) { bf16_t* rowp = O + (size_t)(row0 + ai * HALF + m * 16) * ldc + col0;
#pragma unroll
                for (int bj = 0; bj < 2; ++bj) { f32x4 v0 = acc[ai][bj][m][0], v1 = acc[ai][bj][m][1];
                    if (ACT == 2) {
#pragma unroll
                        for (int e = 0; e < 4; ++e) { const float a = v0[e] > 0.f ? v0[e] : 0.f, b = v1[e] > 0.f ? v1[e] : 0.f; v0[e] = a * a; v1[e] = b * b; } }
                    v0 = v0 * sc; v1 = v1 * sc; u32x4 w; w.x = cvt_pk_bf16(v0[0], v0[1]); w.y = cvt_pk_bf16(v0[2], v0[3]); w.z = cvt_pk_bf16(v1[0], v1[1]); w.w = cvt_pk_bf16(v1[2], v1[3]);
                    *(u32x4*)(rowp + bj * HALF) = w; } }
    }
};
struct EpiResF32 {
    static constexpr bool PERM = false, AFTER_DRAIN = false;
    const float* base; float* out; int ldc; float alpha;
    __device__ __forceinline__ void operator()(const f32x4 (&acc)[2][2][4][2], const Unit& u, int wr, int wc, int fr, int fq) const {
        const int col0 = u.pn * BM + wc * 32 + 4 * fq;
#pragma unroll
        for (int ai = 0; ai < 2; ++ai)
#pragma unroll
            for (int m = 0; m < 4; ++m) { const size_t off = (size_t)(u.pm * BM + ai * HALF + wr * 64 + m * 16 + fr) * ldc + col0;
#pragma unroll
                for (int bj = 0; bj < 2; ++bj)
#pragma unroll
                    for (int n = 0; n < 2; ++n) { const f32x4 bs = *(const f32x4*)(base + off + bj * HALF + n * 16); const f32x4 o = bs * alpha + acc[ai][bj][m][n]; *(f32x4*)(out + off + bj * HALF + n * 16) = o; }
                asm volatile("" ::: "memory"); }
    }
};
template <class Epi, class Sched, bool ALIGN_EPI = false, bool SP2 = false>
__device__ __forceinline__ void gemm_phase(PG8_LAS unsigned char* lds, const Gemm g, const Sched& S, const Epi& E) {
    const int tid = threadIdx.x, wid = __builtin_amdgcn_readfirstlane(tid >> 6), lane = tid & 63, wr = wid >> 2, wc = wid & 3, fr = lane & 15, fq = lane >> 4;
    const int K = g.K, nt = K / BK;
    unsigned voffA[2], voffB[2];
#pragma unroll
    for (int i = 0; i < 2; ++i) { int R, C; stage_rc(tid * 16 + i * 8192, R, C); const int Rb = Epi::PERM ? ((R & ~31) + perm32(R & 31)) : R;
        voffA[i] = (unsigned)(R * K + C) * 2u; voffB[i] = (unsigned)(Rb * K + C) * 2u; }
    const size_t kstep = (size_t)(BK * 2);
    const size_t hstep = (size_t)HALF * K * 2;
    const size_t tstep = 2 * hstep;
    const unsigned ldsw = (unsigned)wid * 1024u;
    const int aoff = lds_byte(wr * 64 + fr, fq * 8), boff = lds_byte(wc * 32 + fr, fq * 8);
#define PG8_SA(b, h) (((b) * 2 + (h)) * HTB)
#define PG8_SB(b, h) ((4 + (b) * 2 + (h)) * HTB)
#define PG8_STAGE(bufoff, gbase, voff) do { _Pragma("unroll") for (int _i = 0; _i < 2; ++_i) \
        __builtin_amdgcn_global_load_lds((const unsigned*)((const char*)(gbase) + (voff)[_i]), (PG8_LAS unsigned*)(lds + (bufoff) + ldsw + _i * 8192), 16, 0, 0); } while (0)
#define PG8_LDA(dst, b, h) do { _Pragma("unroll") for (int m = 0; m < 4; ++m) _Pragma("unroll") for (int k = 0; k < 2; ++k) dst[m][k] = *(const PG8_LAS bf16x8*)(lds + PG8_SA(b, h) + aoff + m * 2048 + k * 1024); } while (0)
#define PG8_LDB(dst, b, h) do { _Pragma("unroll") for (int n = 0; n < 2; ++n) _Pragma("unroll") for (int k = 0; k < 2; ++k) dst[n][k] = *(const PG8_LAS bf16x8*)(lds + PG8_SB(b, h) + boff + n * 2048 + k * 1024); } while (0)
#define PG8_MMA(ai, bj, At, Bt) do { __builtin_amdgcn_s_setprio(1); _Pragma("unroll") for (int m = 0; m < 4; ++m) _Pragma("unroll") for (int n = 0; n < 2; ++n) _Pragma("unroll") for (int k = 0; k < 2; ++k) \
        acc[ai][bj][m][n] = __builtin_amdgcn_mfma_f32_16x16x32_bf16(Bt[n][k], At[m][k], acc[ai][bj][m][n], 0, 0, 0); __builtin_amdgcn_s_setprio(0); } while (0)
#define PG8_WAIT_V(n) asm volatile("s_waitcnt vmcnt(" #n ")" ::: "memory")
#define PG8_WAIT_L(n) asm volatile("s_waitcnt lgkmcnt(" #n ")" ::: "memory")
#define PG8_BAR __builtin_amdgcn_s_barrier()
#define PG8_SCHED __builtin_amdgcn_sched_barrier(0)
    Unit cur, nxt; int ui = 0;
    if (!S.next(0, cur)) return;
    f32x4 acc[2][2][4][2];
#pragma unroll
    for (int a = 0; a < 2; ++a)
#pragma unroll
        for (int b = 0; b < 2; ++b)
#pragma unroll
            for (int m = 0; m < 4; ++m)
#pragma unroll
                for (int n = 0; n < 2; ++n) acc[a][b][m][n] = (f32x4){0.f, 0.f, 0.f, 0.f};
    bf16x8 At[4][2], B0[2][2], B1[2][2];
    const char* cA = (const char*)g.A + (size_t)cur.pm * tstep; const char* cB = (const char*)g.Bt + (size_t)cur.pn * tstep;
    S.a_ready(cur);
    if constexpr (SP2) {
        PG8_STAGE(PG8_SB(0, 0), cB, voffB); PG8_STAGE(PG8_SB(0, 1), cB + hstep, voffB); PG8_STAGE(PG8_SA(0, 0), cA, voffA); PG8_STAGE(PG8_SA(0, 1), cA + hstep, voffA);
        if (wr == 1) PG8_BAR;
        PG8_WAIT_V(2); PG8_BAR;
        PG8_STAGE(PG8_SB(1, 0), cB + kstep, voffB); PG8_STAGE(PG8_SA(1, 0), cA + kstep, voffA); PG8_STAGE(PG8_SB(1, 1), cB + hstep + kstep, voffB);
        PG8_WAIT_V(6); PG8_BAR;
    } else {
        PG8_STAGE(PG8_SB(0, 0), cB, voffB); PG8_STAGE(PG8_SA(0, 0), cA, voffA); PG8_STAGE(PG8_SB(0, 1), cB + hstep, voffB); PG8_STAGE(PG8_SA(0, 1), cA + hstep, voffA);
        if (wr == 1) PG8_BAR;
        PG8_WAIT_V(4); PG8_BAR;
        PG8_STAGE(PG8_SB(1, 0), cB + kstep, voffB); PG8_STAGE(PG8_SA(1, 0), cA + kstep, voffA); PG8_STAGE(PG8_SB(1, 1), cB + hstep + kstep, voffB);
        PG8_WAIT_V(6); PG8_BAR;
    }
    for (;;) {
        const bool has_next = S.next(ui + 1, nxt);
        const char* nA = has_next ? (const char*)g.A + (size_t)nxt.pm * tstep : cA; const char* nB = has_next ? (const char*)g.Bt + (size_t)nxt.pn * tstep : cB;
        for (int t = 0; t < nt; t += 2) {
            const bool last = (t == nt - 2);
            const char* a1 = cA + (size_t)(t + 1) * kstep;
            const char* a2 = last ? nA : cA + (size_t)(t + 2) * kstep; const char* b2 = last ? nB : cB + (size_t)(t + 2) * kstep;
            const char* a3 = a2 + kstep; const char* b3 = b2 + kstep;
            if (last && has_next) S.a_ready(nxt);
            if constexpr (SP2) {
            PG8_LDB(B0, 0, 0); PG8_LDB(B1, 0, 1); PG8_SCHED; PG8_LDA(At, 0, 0); PG8_STAGE(PG8_SA(1, 1), a1 + hstep, voffA);
            PG8_WAIT_V(8); PG8_WAIT_L(0); PG8_BAR; PG8_MMA(0, 0, At, B0); PG8_MMA(0, 1, At, B1); PG8_BAR; PG8_SCHED;
            PG8_LDA(At, 0, 1); PG8_STAGE(PG8_SB(0, 0), b2, voffB); PG8_STAGE(PG8_SB(0, 1), b2 + hstep, voffB); PG8_STAGE(PG8_SA(0, 0), a2, voffA);
            PG8_WAIT_V(8); PG8_WAIT_L(0); PG8_BAR; PG8_MMA(1, 0, At, B0); PG8_MMA(1, 1, At, B1); PG8_BAR; PG8_SCHED;
            PG8_LDB(B0, 1, 0); PG8_LDB(B1, 1, 1); PG8_SCHED; PG8_LDA(At, 1, 0); PG8_STAGE(PG8_SA(0, 1), a2 + hstep, voffA);
            PG8_WAIT_V(8); PG8_WAIT_L(0); PG8_BAR; PG8_MMA(0, 0, At, B0); PG8_MMA(0, 1, At, B1); PG8_BAR; PG8_SCHED;
            PG8_LDA(At, 1, 1); PG8_STAGE(PG8_SB(1, 0), b3, voffB); PG8_STAGE(PG8_SB(1, 1), b3 + hstep, voffB); PG8_STAGE(PG8_SA(1, 0), a3, voffA);
            PG8_WAIT_V(8); PG8_WAIT_L(0); PG8_BAR; PG8_MMA(1, 0, At, B0); PG8_MMA(1, 1, At, B1); PG8_BAR; PG8_SCHED;
            } else {
            PG8_LDB(B0, 0, 0); PG8_SCHED; PG8_LDA(At, 0, 0); PG8_STAGE(PG8_SA(1, 1), a1 + hstep, voffA);
            PG8_WAIT_L(8); PG8_BAR; PG8_WAIT_L(0); PG8_MMA(0, 0, At, B0); PG8_BAR; PG8_SCHED;
            PG8_LDB(B1, 0, 1); PG8_STAGE(PG8_SB(0, 0), b2, voffB);
            PG8_BAR; PG8_WAIT_L(0); PG8_MMA(0, 1, At, B1); PG8_BAR;
            PG8_LDA(At, 0, 1); PG8_STAGE(PG8_SA(0, 0), a2, voffA);
            PG8_BAR; PG8_WAIT_L(0); PG8_MMA(1, 0, At, B0); PG8_BAR; PG8_SCHED;
            PG8_STAGE(PG8_SB(0, 1), b2 + hstep, voffB);
            PG8_WAIT_V(6); PG8_BAR; PG8_MMA(1, 1, At, B1); PG8_BAR;
            PG8_LDB(B0, 1, 0); PG8_SCHED; PG8_LDA(At, 1, 0); PG8_STAGE(PG8_SA(0, 1), a2 + hstep, voffA);
            PG8_WAIT_L(8); PG8_BAR; PG8_WAIT_L(0); PG8_MMA(0, 0, At, B0); PG8_BAR; PG8_SCHED;
            PG8_LDB(B1, 1, 1); PG8_STAGE(PG8_SB(1, 0), b3, voffB);
            PG8_BAR; PG8_WAIT_L(0); PG8_MMA(0, 1, At, B1); PG8_BAR;
            PG8_LDA(At, 1, 1); PG8_STAGE(PG8_SA(1, 0), a3, voffA);
            PG8_BAR; PG8_WAIT_L(0); PG8_MMA(1, 0, At, B0); PG8_BAR; PG8_SCHED;
            PG8_STAGE(PG8_SB(1, 1), b3 + hstep, voffB);
            PG8_WAIT_V(6); PG8_BAR; PG8_MMA(1, 1, At, B1); PG8_BAR;
            }
        }
        if constexpr (ALIGN_EPI) { if (wr == 0) PG8_BAR; }
        if constexpr (!Epi::AFTER_DRAIN) { E(acc, cur, wr, wc, fr, fq); S.done(cur); }
        if (!has_next) break;
#pragma unroll
        for (int a = 0; a < 2; ++a)
#pragma unroll
            for (int b = 0; b < 2; ++b)
#pragma unroll
                for (int m = 0; m < 4; ++m)
#pragma unroll
                    for (int n = 0; n < 2; ++n) acc[a][b][m][n] = (f32x4){0.f, 0.f, 0.f, 0.f};
        cur = nxt; cA = nA; cB = nB; ++ui;
        if constexpr (ALIGN_EPI) { if (wr == 1) PG8_BAR; }
    }
    PG8_WAIT_V(0);
    if constexpr (!ALIGN_EPI) { if (wr == 0) PG8_BAR; }
    PG8_BAR;
    if constexpr (Epi::AFTER_DRAIN) { E.fused(acc, cur, wr, wc, fr, fq, lds, wid, lane); S.done(cur); }
#undef PG8_SA
#undef PG8_SB
#undef PG8_STAGE
#undef PG8_LDA
#undef PG8_LDB
#undef PG8_MMA
#undef PG8_WAIT_V
#undef PG8_WAIT_L
#undef PG8_BAR
#undef PG8_SCHED
}
}
#define LAS __attribute__((address_space(3)))
typedef pg8::bf16_t bf16;
typedef unsigned u32x4 __attribute__((ext_vector_type(4)));
typedef unsigned u32x2 __attribute__((ext_vector_type(2)));
typedef float f32x4 __attribute__((ext_vector_type(4)));
typedef float f32x16 __attribute__((ext_vector_type(16)));
typedef short bf16x8 __attribute__((ext_vector_type(8)));
typedef short s16x4 __attribute__((ext_vector_type(4)));
constexpr int NWAVES = 8, NTHR = 512;
constexpr int DM = 2048, BATCH = 8, SEQ = 2048, M = BATCH * SEQ, INC = 6144, DFF = 8192, NCH = 1024;
constexpr float ALPHA = 1.189207115002721f;
constexpr float LN_EPS = 1e-5f, LOG2E = 1.4426950408889634f, QSCALE = 0.125f * LOG2E;
constexpr size_t MiB = 1u << 20;
constexpr size_t WS_WIN = 1 * MiB, WS_WOUT = 25 * MiB, WS_WFF1 = 33 * MiB, WS_WFF2 = 65 * MiB;
constexpr size_t WS_XB = 97 * MiB;
constexpr size_t WS_PROJ = 161 * MiB;
constexpr size_t WS_X1B = 353 * MiB;
constexpr size_t WS_YT = 353 * MiB, WS_VGT = 417 * MiB, WS_X1T = 449 * MiB, WS_FILT = 481 * MiB;
constexpr size_t WS_H = 97 * MiB;
constexpr size_t WS_END = 489 * MiB;
constexpr int LDS_BYTES = 131072;

__device__ __forceinline__ unsigned pk2(float lo, float hi) { return pg8::cvt_pk_bf16(lo, hi); }
__device__ __forceinline__ unsigned short f2bf(float f) { unsigned u = __builtin_bit_cast(unsigned, f); return (unsigned short)((u + 0x7fffu + ((u >> 16) & 1u)) >> 16); }
__device__ __forceinline__ float bflo(unsigned w) { return __uint_as_float(w << 16); }
__device__ __forceinline__ float bfhi(unsigned w) { return __uint_as_float(w & 0xffff0000u); }
__device__ __forceinline__ float wave_sum(float v) {
#pragma unroll
    for (int o = 1; o < 64; o <<= 1) v += __shfl_xor(v, o);
    return v;
}
__device__ __forceinline__ float half_swap_max(float v) { auto rr = __builtin_amdgcn_permlane32_swap(__float_as_uint(v), __float_as_uint(v), false, false); return fmaxf(__uint_as_float(rr[0]), __uint_as_float(rr[1])); }
__device__ __forceinline__ float half_swap_sum(float v) { auto rr = __builtin_amdgcn_permlane32_swap(__float_as_uint(v), __float_as_uint(v), false, false); return __uint_as_float(rr[0]) + __uint_as_float(rr[1]); }

struct Frame {
    LAS unsigned char* lds;
    int tid, lane, wave, vcu, G;
    const float *x, *w_in, *lq1, *lk1, *lq2, *lk2, *subg, *conv_w, *conv_b, *fw1, *fb1, *ffreq, *fw2, *fb2, *fw3, *hskip, *hgain, *w_out, *ln1g, *ln1b, *w_ff1, *w_ff2, *ln2g, *ln2b;
    float* out;
    bf16 *WinT, *WoutT, *Wff1T, *Wff2T, *xb, *mix, *proj, *x1b, *yT, *vgT, *x1T, *filt, *hbuf;
};

__device__ __forceinline__ void p0_transpose_item(const float* W, int K, int N, bf16* WT, LAS float* scr, int item, int lane) {
    const int nblk = N / 32, kb = item / nblk, nb = item % nblk, k0 = 64 * kb, n0 = 32 * nb;
#pragma unroll 8
    for (int i = 0; i < 32; ++i) { const int kk = 2 * i + (lane >> 5); scr[kk * 33 + (lane & 31)] = W[(size_t)(k0 + kk) * N + n0 + (lane & 31)]; }
    asm volatile("s_waitcnt lgkmcnt(0)" ::: "memory");
    const int c = lane & 7;
#pragma unroll
    for (int j = 0; j < 4; ++j) { const int n = (lane >> 3) + 8 * j; const LAS float* s = scr + (8 * c) * 33 + n;
        u32x4 o; o.x = pk2(s[0 * 33], s[1 * 33]); o.y = pk2(s[2 * 33], s[3 * 33]); o.z = pk2(s[4 * 33], s[5 * 33]); o.w = pk2(s[6 * 33], s[7 * 33]);
        *(u32x4*)(WT + (size_t)(n0 + n) * K + k0 + 8 * c) = o; }
    asm volatile("s_waitcnt lgkmcnt(0)" ::: "memory");
}
__device__ __forceinline__ void filter_item(Frame& F, int it) {
    LAS float* zs = (LAS float*)F.lds; LAS float* h1s = zs + 16 * 33; LAS float* h2s = h1s + 16 * 64;
    const int tid = F.tid, l0 = it * 16;
    for (int idx = tid; idx < 16 * 33; idx += NTHR) { const int r = idx / 33, e = idx - r * 33, l = l0 + r; float val;
        if (e == 0) val = (float)l / 2047.0f;
        else { const int j = (e - 1) & 15; const float f = 1e-4f + (float)j * ((15.0f - 1e-4f) / 15.0f); const float w = (6.283185307179586f * (float)l) / 2048.0f; const float a = f * w; val = (e <= 16) ? __cosf(a) : -__sinf(a); }
        zs[idx] = val; }
    __syncthreads();
    for (int idx = tid; idx < 1024; idx += NTHR) { const int r = idx >> 6, o = idx & 63; float a = F.fb1[o];
        for (int e = 0; e < 33; ++e) a += zs[r * 33 + e] * F.fw1[e * 64 + o];
        h1s[idx] = __sinf(F.ffreq[o] * a); }
    __syncthreads();
    for (int idx = tid; idx < 1024; idx += NTHR) { const int r = idx >> 6, o = idx & 63; float a = F.fb2[o];
        for (int e = 0; e < 64; ++e) a += h1s[r * 64 + e] * F.fw2[e * 64 + o];
        h2s[idx] = __sinf(F.ffreq[o] * a); }
    __syncthreads();
    const int n0 = tid * 4;
    f32x4 acc[16];
#pragma unroll
    for (int r = 0; r < 16; ++r) acc[r] = (f32x4){0.f, 0.f, 0.f, 0.f};
    for (int k = 0; k < 64; k += 4) {
        const f32x4 w0 = *(const f32x4*)(F.fw3 + (size_t)(k + 0) * 2048 + n0), w1 = *(const f32x4*)(F.fw3 + (size_t)(k + 1) * 2048 + n0),
                    w2 = *(const f32x4*)(F.fw3 + (size_t)(k + 2) * 2048 + n0), w3 = *(const f32x4*)(F.fw3 + (size_t)(k + 3) * 2048 + n0);
#pragma unroll
        for (int r = 0; r < 16; ++r) { const f32x4 hv = *(const LAS f32x4*)(h2s + r * 64 + k); acc[r] += w0 * hv.x + w1 * hv.y + w2 * hv.z + w3 * hv.w; }
    }
    const int ch0 = n0 & 1023; const bool fwd = n0 < 1024;
    const float DMIN = -3.0701134573253945f, DMAX = -15.350567286626972f;
#pragma unroll
    for (int e = 0; e < 4; ++e) { const int ch = ch0 + e; const float ad = fabsf(DMIN + (float)ch * ((DMAX - DMIN) / 1023.0f)); bf16* dst = F.filt + (size_t)ch * 4096;
#pragma unroll
        for (int r = 0; r < 16; ++r) { const int l = l0 + r; const float tl = (float)l / 2047.0f; const float val = acc[r][e] * __expf(-tl * ad);
            if (fwd) dst[2048 - l] = f2bf(val); else if (l >= 1) dst[2048 + l] = f2bf(val); }
        if (it == 0 && fwd) dst[0] = 0; }
    __syncthreads();
}
__device__ __forceinline__ void h1_item(Frame& F, int item) {
    const int cblk = item & 15, sblk = (item >> 4) & 31, b = item >> 9;
    const int tid = F.tid, s_l = tid >> 3, cg8 = tid & 7;
    const int s = sblk * 64 + s_l, c = cblk * 64 + cg8 * 8;
    const bf16* row = F.proj + ((size_t)(b * SEQ + s)) * INC + 3072 + c;
    float z[3][8];
#pragma unroll
    for (int a = 0; a < 3; ++a) { const bf16* p = row + a * 1024;
        u32x4 um = (u32x4){0u, 0u, 0u, 0u}, up = (u32x4){0u, 0u, 0u, 0u}; const u32x4 u0 = *(const u32x4*)p;
        if (s > 0) um = *(const u32x4*)(p - INC);
        if (s < SEQ - 1) up = *(const u32x4*)(p + INC);
        const float* cw = F.conv_w + a * 1024 + c; const float* cb = F.conv_b + a * 1024 + c;
#pragma unroll
        for (int e2 = 0; e2 < 4; ++e2) {
            const float m0 = bflo(um[e2]), m1 = bfhi(um[e2]), c0 = bflo(u0[e2]), c1 = bfhi(u0[e2]), p0 = bflo(up[e2]), p1 = bfhi(up[e2]);
            z[a][2 * e2]     = cb[2 * e2]     + m0 * cw[2 * e2]     + c0 * cw[3072 + 2 * e2]     + p0 * cw[6144 + 2 * e2];
            z[a][2 * e2 + 1] = cb[2 * e2 + 1] + m1 * cw[2 * e2 + 1] + c1 * cw[3072 + 2 * e2 + 1] + p1 * cw[6144 + 2 * e2 + 1]; } }
    LAS unsigned short* tv = (LAS unsigned short*)F.lds; LAS unsigned short* tx = tv + 64 * 66;
#pragma unroll
    for (int e = 0; e < 8; ++e) { tv[(cg8 * 8 + e) * 66 + s_l] = f2bf(z[2][e] * z[1][e]); tx[(cg8 * 8 + e) * 66 + s_l] = f2bf(z[0][e]); }
    __syncthreads();
    { const int c_l = tid >> 3, chunk = tid & 7;
      const LAS unsigned* pv = (const LAS unsigned*)(F.lds + c_l * 132 + chunk * 16); const LAS unsigned* px = (const LAS unsigned*)(F.lds + 64 * 132 + c_l * 132 + chunk * 16);
      u32x4 ov, ox; ov.x = pv[0]; ov.y = pv[1]; ov.z = pv[2]; ov.w = pv[3]; ox.x = px[0]; ox.y = px[1]; ox.z = px[2]; ox.w = px[3];
      const size_t go = ((size_t)((cblk * 64 + c_l) * 8 + b)) * 2048 + sblk * 64 + chunk * 8;
      *(u32x4*)(F.vgT + go) = ov; *(u32x4*)(F.x1T + go) = ox; }
    __syncthreads();
}
namespace att {
constexpr int KOFF = 0, VOFF = 32768, QOFF = 65536;
__device__ __forceinline__ int toff(int row, int ch) { return 256 * row + 16 * (ch ^ (((row & 3) << 2) | ((row >> 2) & 3))); }
#define MFMA32(a, b, c) __builtin_amdgcn_mfma_f32_32x32x16_bf16((a), (b), (c), 0, 0, 0)
__device__ __forceinline__ void glds16(const void* gsrc, unsigned lds_dst) { unsigned keep;
    asm volatile("s_mov_b32 %0, m0\n\ts_mov_b32 m0, %2\n\ts_nop 0\n\tglobal_load_lds_dwordx4 %1, off\n\ts_mov_b32 m0, %0" : "=&s"(keep) : "v"(gsrc), "s"(lds_dst) : "memory"); }
__device__ __forceinline__ float a_add(float a, float b) { float r; asm("v_add_f32_e32 %0, %1, %2" : "=v"(r) : "v"(a), "v"(b)); return r; }
__device__ __forceinline__ float a_sub(float a, float b) { float r; asm("v_sub_f32_e32 %0, %1, %2" : "=v"(r) : "v"(a), "v"(b)); return r; }
__device__ __forceinline__ float a_max3(float a, float b, float c) { float r; asm("v_max3_f32 %0, %1, %2, %3" : "=v"(r) : "v"(a), "v"(b), "v"(c)); return r; }
__device__ __forceinline__ float a_bias(float nsl2, float t, float negm) { float r; asm("v_fma_f32 %0, %1, |%2|, %3" : "=v"(r) : "v"(nsl2), "v"(t), "v"(negm)); return r; }
typedef float f32x2_t __attribute__((ext_vector_type(2))); typedef __bf16 bf16x2_t __attribute__((ext_vector_type(2)));
__device__ __forceinline__ unsigned cvtpk_m(float lo, float hi) { f32x2_t v = {lo, hi}; bf16x2_t b = __builtin_convertvector(v, bf16x2_t); return __builtin_bit_cast(unsigned, b); }
template <int K> __device__ __forceinline__ float a_subk(float b) { float r; asm("v_subrev_f32_e32 %0, %1, %2" : "=v"(r) : "n"(__builtin_bit_cast(int, (float)K)), "v"(b)); return r; }
#define ATT_WAIT_BAR(N) asm volatile("s_waitcnt vmcnt(" #N ") lgkmcnt(0)\n\ts_barrier" ::: "memory")
__device__ __forceinline__ s16x4 vtr(const LAS unsigned char* p) { return __builtin_bit_cast(s16x4, __builtin_amdgcn_ds_read_tr16_b64_v4i16((LAS s16x4*)p)); }

__device__ __forceinline__ void attn_unit(LAS unsigned char* lds, const bf16* proj, bf16* mix, int b, int h, int qb, float lam, const float* subg) {
    const int tid = threadIdx.x, lane = tid & 63, r32 = lane & 31, hi = lane >> 5;
    const int wid = __builtin_amdgcn_readfirstlane(tid >> 6);
    const int c = wid >> 2, qi = wid & 3; const bool grpB = (wid >= 4);
    const size_t rowbase = (size_t)b * SEQ;
    const int qpos = qb * 128 + qi * 32 + r32;
    constexpr int NT = SEQ / 64, SLOT = 32768, VO = 16384;
    bf16x8 qf[4];
    { const bf16* qg = proj + (rowbase + qpos) * INC + h * 128 + c * 64 + hi * 8;
#pragma unroll
      for (int d0 = 0; d0 < 4; ++d0) qf[d0] = *(const bf16x8*)(qg + d0 * 16); }
    const bf16* kvg = proj + rowbase * INC + 1024 + h * 128;
    size_t goff[2];
#pragma unroll
    for (int j = 0; j < 2; ++j) { const int row = 8 * wid + 4 * j + (lane >> 4); const int sw = ((lane >> 4) << 2) | ((2 * wid + j) & 3); goff[j] = (size_t)row * INC + 8 * ((lane & 15) ^ sw); }
    const unsigned lds0 = (unsigned)(uintptr_t)lds;
#define ATT_STAGE(t_, slot_) do { const int tt_ = (t_) < NT ? (t_) : NT - 1; const bf16* kt_ = kvg + (size_t)tt_ * 64 * INC; _Pragma("unroll") for (int j_ = 0; j_ < 2; ++j_) { \
        const unsigned d_ = (unsigned)__builtin_amdgcn_readfirstlane((int)(lds0 + (unsigned)((slot_) * SLOT + 256 * (8 * wid + 4 * j_)))); \
        glds16(kt_ + goff[j_], d_); glds16(kt_ + goff[j_] + 1024, d_ + VO); } } while (0)
    ATT_STAGE(0, 0); ATT_STAGE(1, 1);
    asm volatile("s_waitcnt vmcnt(0)" ::: "memory");
    __syncthreads();
    if (grpB) ATT_WAIT_BAR(0);
    const float sl2 = exp2f(-(float)(h + 1)) * LOG2E;
    const int swr = ((r32 & 3) << 2) | ((r32 >> 2) & 3);
    const LAS unsigned char* kbase = lds + 256 * r32;
    const int i16 = lane & 15, g1 = (lane >> 4) & 1;
    int vaddr[4][2];
#pragma unroll
    for (int db = 0; db < 4; ++db)
#pragma unroll
        for (int sec = 0; sec < 2; ++sec) { const int swv = ((i16 >> 2) << 2) | (hi + 2 * sec); const int ch = 4 * db + 2 * g1 + ((i16 & 3) >> 1);
            vaddr[db][sec] = VO + 256 * (4 * hi + (i16 >> 2) + 8 * sec) + 16 * (ch ^ swv) + 8 * (i16 & 1); }
    f32x16 o[4];
#pragma unroll
    for (int db = 0; db < 4; ++db)
#pragma unroll
        for (int i = 0; i < 16; ++i) o[db][i] = 0.f;
    float mref = 0.f, lsum = 0.f;
    int s0 = 0, s1 = 1, s2 = 2;
    for (int t = 0; t < NT; ++t) {
        if (grpB) ATT_STAGE(t + 2, s2);
        f32x16 p[2];
        const float nsl2 = -sl2, negm = -mref;
#pragma unroll
        for (int kh = 0; kh < 2; ++kh) {
            const float basef = (float)(qpos - 64 * t - 32 * kh - 4 * hi);
            f32x16 acc;
#define ATT_CI(i) acc[i] = a_bias(nsl2, a_subk<((i) & 3) + 8 * ((i) >> 2)>(basef), negm)
            ATT_CI(0); ATT_CI(1); ATT_CI(2); ATT_CI(3); ATT_CI(4); ATT_CI(5); ATT_CI(6); ATT_CI(7); ATT_CI(8); ATT_CI(9); ATT_CI(10); ATT_CI(11); ATT_CI(12); ATT_CI(13); ATT_CI(14); ATT_CI(15);
#undef ATT_CI
            asm volatile("s_nop 1" : "+v"(acc));
#pragma unroll
            for (int d0 = 0; d0 < 4; ++d0) { const int ch = c * 8 + d0 * 2 + hi;
                const bf16x8 kf = *(const LAS bf16x8*)(kbase + s0 * SLOT + kh * 8192 + 16 * (ch ^ swr));
                acc = MFMA32(kf, qf[d0], acc); }
            p[kh] = acc;
        }
        asm volatile("s_nop 15\n\ts_nop 7" : "+v"(p[0]), "+v"(p[1]));
        float rm;
        { float ra = a_max3(p[0][0], p[0][1], p[1][0]), rb = a_max3(p[0][2], p[0][3], p[1][1]); ra = a_max3(ra, p[1][2], p[1][3]);
#pragma unroll
          for (int i = 4; i < 16; i += 4) { ra = a_max3(ra, p[0][i], p[0][i + 1]); rb = a_max3(rb, p[0][i + 2], p[0][i + 3]); ra = a_max3(ra, p[1][i], p[1][i + 1]); rb = a_max3(rb, p[1][i + 2], p[1][i + 3]); }
          rm = fmaxf(ra, rb); }
        rm = half_swap_max(rm);
        if (t == 0 || __any(rm > 8.0f)) {
            const float delta = (t == 0) ? rm : fmaxf(rm, 0.f);
            mref += delta;
#pragma unroll
            for (int i = 0; i < 16; ++i) { p[0][i] = a_sub(p[0][i], delta); p[1][i] = a_sub(p[1][i], delta); }
            if (t != 0) { const float f = __builtin_amdgcn_exp2f(-delta); lsum *= f;
#pragma unroll
                for (int db = 0; db < 4; ++db) o[db] = o[db] * f; }
        }
        { float sa = 0.f, sb = 0.f;
#pragma unroll
          for (int i = 0; i < 16; ++i) { p[0][i] = __builtin_amdgcn_exp2f(p[0][i]); p[1][i] = __builtin_amdgcn_exp2f(p[1][i]); }
          asm volatile("s_nop 0" : "+v"(p[0]), "+v"(p[1]));
#pragma unroll
          for (int i = 0; i < 16; ++i) { sa = a_add(sa, p[0][i]); sb = a_add(sb, p[1][i]); }
          lsum = a_add(lsum, a_add(sa, sb)); }
        bf16x8 pfr[4];
#pragma unroll
        for (int kh = 0; kh < 2; ++kh)
#pragma unroll
            for (int sp = 0; sp < 2; ++sp) { u32x4 w; w.x = cvtpk_m(p[kh][8 * sp + 0], p[kh][8 * sp + 1]); w.y = cvtpk_m(p[kh][8 * sp + 2], p[kh][8 * sp + 3]); w.z = cvtpk_m(p[kh][8 * sp + 4], p[kh][8 * sp + 5]); w.w = cvtpk_m(p[kh][8 * sp + 6], p[kh][8 * sp + 7]);
                pfr[2 * kh + sp] = __builtin_bit_cast(bf16x8, w); }
        ATT_WAIT_BAR(4);
        if (!grpB) ATT_STAGE(t + 2, s2);
#pragma unroll
        for (int db = 0; db < 4; ++db)
#pragma unroll
            for (int s = 0; s < 4; ++s) { const LAS unsigned char* vb = lds + s0 * SLOT + 4096 * s;
                const s16x4 lo = vtr(vb + vaddr[db][0]), hi4 = vtr(vb + vaddr[db][1]);
                const bf16x8 vf = (bf16x8){lo[0], lo[1], lo[2], lo[3], hi4[0], hi4[1], hi4[2], hi4[3]};
                o[db] = MFMA32(vf, pfr[s], o[db]); }
        ATT_WAIT_BAR(4);
        { const int tmp = s0; s0 = s1; s1 = s2; s2 = tmp; }
    }
    if (!grpB) ATT_WAIT_BAR(0);
    asm volatile("s_waitcnt vmcnt(0)" ::: "memory");
    __syncthreads();
    const float lt = half_swap_sum(lsum);
    LAS float* xch = (LAS float*)(lds + qi * 16384) + lane;
    if (c == 1) { const float inv = lam / lt;
#pragma unroll
        for (int db = 0; db < 4; ++db)
#pragma unroll
            for (int i = 0; i < 16; ++i) xch[(db * 16 + i) * 64] = o[db][i] * inv; }
    __syncthreads();
    if (c == 0) {
        const float inv = 1.0f / lt; float ss = 0.f;
#pragma unroll
        for (int db = 0; db < 4; ++db)
#pragma unroll
            for (int i = 0; i < 16; ++i) { const float v = o[db][i] * inv - xch[(db * 16 + i) * 64]; o[db][i] = v; ss += v * v; }
        ss = half_swap_sum(ss);
        const float rstd = (1.0f / sqrtf(ss * (1.0f / 128.0f) + LN_EPS)) * 0.8f;
        bf16* orow = mix + (rowbase + qpos) * DM + h * 128;
#pragma unroll
        for (int db = 0; db < 4; ++db)
#pragma unroll
            for (int g = 0; g < 4; ++g) { const int d = 32 * db + 8 * g + 4 * hi; const f32x4 gg = *(const f32x4*)(subg + d);
                u32x2 w; w.x = pk2(o[db][4 * g] * rstd * gg.x, o[db][4 * g + 1] * rstd * gg.y); w.y = pk2(o[db][4 * g + 2] * rstd * gg.z, o[db][4 * g + 3] * rstd * gg.w);
                *(u32x2*)(orow + d) = w; }
    }
    __syncthreads();
}
#undef ATT_STAGE
}

namespace hy {
constexpr int CPS = 8224, VGO = 8 * CPS, VGS = 4112, RSTG = VGO + 8 * VGS;
#define MFMA16(a, b, c) __builtin_amdgcn_mfma_f32_16x16x32_bf16((a), (b), (c), 0, 0, 0)
__device__ __forceinline__ void conv_unit(LAS unsigned char* lds, int c, const bf16* filt, const bf16* vgT, const bf16* x1T, bf16* yT, const float* dskip) {
    const int tid = threadIdx.x, lane = tid & 63; const int wid = __builtin_amdgcn_readfirstlane(tid >> 6);
    *(LAS u32x4*)(lds + RSTG + tid * 16) = *(const u32x4*)(filt + (size_t)c * 4096 + tid * 8);
#pragma unroll
    for (int k = 0; k < 4; ++k) { const int id = tid + 512 * k, bb = id >> 8, ch = id & 255; *(LAS u32x4*)(lds + VGO + bb * VGS + ch * 16) = *(const u32x4*)(vgT + ((size_t)(c * 8 + bb)) * 2048 + ch * 8); }
    __syncthreads();
    { const LAS unsigned short* R = (const LAS unsigned short*)(lds + RSTG);
      for (int id = tid; id < 8 * 513; id += NTHR) { const int sh = id / 513, m = id - sh * 513; const int n0 = 8 * m - sh; unsigned w[4];
#pragma unroll
          for (int jj = 0; jj < 4; ++jj) { const int na = n0 + 2 * jj, nb = na + 1; const unsigned lo = (na >= 0 && na < 4096) ? (unsigned)R[na] : 0u; const unsigned hi = (nb >= 0 && nb < 4096) ? (unsigned)R[nb] : 0u; w[jj] = lo | (hi << 16); }
          *(LAS u32x4*)(lds + sh * CPS + m * 16) = (u32x4){w[0], w[1], w[2], w[3]}; } }
    __syncthreads();
    const int i = lane & 15, kq = lane >> 4;
    f32x4 acc[16];
#pragma unroll
    for (int a = 0; a < 16; ++a) acc[a] = (f32x4){0.f, 0.f, 0.f, 0.f};
    const LAS unsigned char* abase = lds + (i & 7) * CPS + 16 * (256 - 32 * wid - (i >> 3) + kq - 30);
    const LAS unsigned char* bbase = lds + VGO + (i & 7) * VGS + 16 * kq;
    for (int sc = 0; sc < 4; ++sc) {
        bf16x8 bfr[16];
#pragma unroll
        for (int ci = 0; ci < 16; ++ci) bfr[ci] = *(const LAS bf16x8*)(bbase + 64 * (16 * sc + ci));
        const LAS unsigned char* ab = abase + 1024 * sc;
#pragma unroll
        for (int vv = 0; vv < 46; ++vv) {
            const bf16x8 af = *(const LAS bf16x8*)(ab + 32 * vv);
#pragma unroll
            for (int ci = 0; ci < 16; ++ci) { const int ai = 2 * ci - (vv - 15); if (ai >= 0 && ai < 16) acc[ai] = MFMA16(af, bfr[ci], acc[ai]); }
        }
    }
    if (i < 8) {
        const float dsk = dskip[c];
#pragma unroll
        for (int ai = 0; ai < 16; ++ai) { const int t = 16 * (16 * wid + ai) + 4 * kq;
            const u32x2 vg = *(const LAS u32x2*)(lds + VGO + i * VGS + 2 * t); const u32x2 x1 = *(const u32x2*)(x1T + ((size_t)(c * 8 + i)) * 2048 + t);
            const float y0 = (acc[ai][0] + bflo(vg.x) * dsk) * bflo(x1.x), y1 = (acc[ai][1] + bfhi(vg.x) * dsk) * bfhi(x1.x), y2 = (acc[ai][2] + bflo(vg.y) * dsk) * bflo(x1.y), y3 = (acc[ai][3] + bfhi(vg.y) * dsk) * bfhi(x1.y);
            u32x2 w; w.x = pk2(y0, y1); w.y = pk2(y2, y3); *(u32x2*)(yT + ((size_t)(c * 8 + i)) * 2048 + t) = w; }
    }
    __syncthreads();
}
}

__device__ __forceinline__ void h3_item(Frame& F, int item) {
    constexpr int RS = 2064;
    const int b = item >> 6, t0 = (item & 63) * 32, tid = F.tid;
#pragma unroll
    for (int k = 0; k < 8; ++k) { const int id = tid + 512 * k, c = id >> 2, chunk = id & 3;
        const u32x4 v = *(const u32x4*)(F.yT + ((size_t)(c * 8 + b)) * 2048 + t0 + chunk * 8);
        LAS unsigned char* base = F.lds + (chunk * 8) * RS + c * 2;
        *(LAS unsigned short*)(base + 0 * RS) = (unsigned short)(v.x & 0xffffu); *(LAS unsigned short*)(base + 1 * RS) = (unsigned short)(v.x >> 16);
        *(LAS unsigned short*)(base + 2 * RS) = (unsigned short)(v.y & 0xffffu); *(LAS unsigned short*)(base + 3 * RS) = (unsigned short)(v.y >> 16);
        *(LAS unsigned short*)(base + 4 * RS) = (unsigned short)(v.z & 0xffffu); *(LAS unsigned short*)(base + 5 * RS) = (unsigned short)(v.z >> 16);
        *(LAS unsigned short*)(base + 6 * RS) = (unsigned short)(v.w & 0xffffu); *(LAS unsigned short*)(base + 7 * RS) = (unsigned short)(v.w >> 16); }
    __syncthreads();
    const int t_l = tid >> 4, cgp = tid & 15;
    u32x4 d[8]; float ss = 0.f;
#pragma unroll
    for (int k = 0; k < 8; ++k) { d[k] = *(const LAS u32x4*)(F.lds + t_l * RS + (16 * k + cgp) * 16);
#pragma unroll
        for (int e = 0; e < 4; ++e) { const float a = bflo(d[k][e]), bq = bfhi(d[k][e]); ss += a * a + bq * bq; } }
    ss += __shfl_xor(ss, 1); ss += __shfl_xor(ss, 2); ss += __shfl_xor(ss, 4); ss += __shfl_xor(ss, 8);
    const float rstd = 1.0f / sqrtf(ss * (1.0f / 1024.0f) + LN_EPS);
    bf16* orow = F.mix + ((size_t)(b * SEQ + t0 + t_l)) * DM + 1024;
#pragma unroll
    for (int k = 0; k < 8; ++k) { const int c0 = (16 * k + cgp) * 8; const f32x4 g0 = *(const f32x4*)(F.hgain + c0), g1 = *(const f32x4*)(F.hgain + c0 + 4);
        u32x4 w; w.x = pk2(bflo(d[k].x) * rstd * g0.x, bfhi(d[k].x) * rstd * g0.y); w.y = pk2(bflo(d[k].y) * rstd * g0.z, bfhi(d[k].y) * rstd * g0.w);
        w.z = pk2(bflo(d[k].z) * rstd * g1.x, bfhi(d[k].z) * rstd * g1.y); w.w = pk2(bflo(d[k].w) * rstd * g1.z, bfhi(d[k].w) * rstd * g1.w);
        *(u32x4*)(orow + c0) = w; }
    __syncthreads();
}
__device__ __forceinline__ void ln_rows(Frame& F, float* buf, const float* g, const float* bt, bf16* ob) {
    const int gw = blockIdx.x * NWAVES + F.wave, NGW = F.G * NWAVES;
    for (int m = gw; m < M; m += NGW) {
        f32x4* row = (f32x4*)(buf + (size_t)m * DM) + F.lane;
        f32x4 v[8]; float s = 0.f;
#pragma unroll
        for (int j = 0; j < 8; ++j) { v[j] = row[64 * j]; s += (v[j].x + v[j].y) + (v[j].z + v[j].w); }
        const float mean = wave_sum(s) * (1.0f / DM); float s2 = 0.f;
#pragma unroll
        for (int j = 0; j < 8; ++j) { v[j] = v[j] - mean; s2 += (v[j].x * v[j].x + v[j].y * v[j].y) + (v[j].z * v[j].z + v[j].w * v[j].w); }
        const float rstd = 1.0f / sqrtf(wave_sum(s2) * (1.0f / DM) + LN_EPS);
#pragma unroll
        for (int j = 0; j < 8; ++j) { const f32x4 gg = ((const f32x4*)g)[F.lane + 64 * j], bb = ((const f32x4*)bt)[F.lane + 64 * j]; const f32x4 y = v[j] * rstd * gg + bb; row[64 * j] = y;
            if (ob) { u32x2 w; w.x = pk2(y.x, y.y); w.y = pk2(y.z, y.w); *((u32x2*)(ob + (size_t)m * DM) + F.lane + 64 * j) = w; } }
    }
}
struct Args { const float* in[24]; float* out; unsigned char* ws; int ph_lo, ph_hi; };
constexpr int N_PHASES = 10;
__global__ void __launch_bounds__(NTHR, 2) hymba_fwd(Args args) {
    extern __shared__ __attribute__((aligned(16))) unsigned char lds_raw[];
    Frame F;
    F.lds = (LAS unsigned char*)lds_raw;
    F.tid = threadIdx.x; F.lane = F.tid & 63; F.wave = __builtin_amdgcn_readfirstlane(F.tid >> 6);
    F.G = gridDim.x; { const int bx = blockIdx.x; F.vcu = (F.G % 8 == 0) ? (bx % 8) * (F.G / 8) + bx / 8 : bx; }
    unsigned char* ws = args.ws;
    F.x = args.in[0]; F.w_in = args.in[1]; F.lq1 = args.in[2]; F.lk1 = args.in[3]; F.lq2 = args.in[4]; F.lk2 = args.in[5]; F.subg = args.in[6]; F.conv_w = args.in[7]; F.conv_b = args.in[8];
    F.fw1 = args.in[9]; F.fb1 = args.in[10]; F.ffreq = args.in[11]; F.fw2 = args.in[12]; F.fb2 = args.in[13]; F.fw3 = args.in[14]; F.hskip = args.in[15]; F.hgain = args.in[16];
    F.w_out = args.in[17]; F.ln1g = args.in[18]; F.ln1b = args.in[19]; F.w_ff1 = args.in[20]; F.w_ff2 = args.in[21]; F.ln2g = args.in[22]; F.ln2b = args.in[23]; F.out = args.out;
    F.WinT = (bf16*)(ws + WS_WIN); F.WoutT = (bf16*)(ws + WS_WOUT); F.Wff1T = (bf16*)(ws + WS_WFF1); F.Wff2T = (bf16*)(ws + WS_WFF2);
    F.xb = (bf16*)(ws + WS_XB); F.mix = (bf16*)(ws + WS_XB); F.proj = (bf16*)(ws + WS_PROJ); F.x1b = (bf16*)(ws + WS_X1B); F.yT = (bf16*)(ws + WS_YT);
    F.vgT = (bf16*)(ws + WS_VGT); F.x1T = (bf16*)(ws + WS_X1T); F.filt = (bf16*)(ws + WS_FILT); F.hbuf = (bf16*)(ws + WS_H);
    const int lo = args.ph_lo, hi = args.ph_hi;
#ifndef PHMASK
#define PHMASK 0x3ff
#endif
#define IN(k) ((((PHMASK) >> (k)) & 1) && lo <= (k) && (k) < hi)
#ifndef REPMASK
#define REPMASK 0
#endif
#define REP(k) for (int rep_ = 0; rep_ < ((((REPMASK) >> (k)) & 1) ? 2 : 1); ++rep_)
#define SEAM(k) do { if (IN(k) && IN((k) + 1)) cg::this_grid().sync(); } while (0)

    if (IN(0)) REP(0) {
        { LAS float* scr = (LAS float*)(F.lds + F.wave * 8704);
          const int gw = F.vcu * NWAVES + F.wave, NGW = F.G * NWAVES;
          constexpr int I_IN = (DM / 64) * (INC / 32), I_OUT = (DM / 64) * (DM / 32), I_F1 = (DM / 64) * (DFF / 32), I_F2 = (DFF / 64) * (DM / 32);
          for (int it = gw; it < I_IN + I_OUT + I_F1 + I_F2; it += NGW) { int r = it;
              if (r < I_IN) { p0_transpose_item(F.w_in, DM, INC, F.WinT, scr, r, F.lane); continue; } r -= I_IN;
              if (r < I_OUT) { p0_transpose_item(F.w_out, DM, DM, F.WoutT, scr, r, F.lane); continue; } r -= I_OUT;
              if (r < I_F1) { p0_transpose_item(F.w_ff1, DM, DFF, F.Wff1T, scr, r, F.lane); continue; } r -= I_F1;
              p0_transpose_item(F.w_ff2, DFF, DM, F.Wff2T, scr, r, F.lane); } }
        __syncthreads();
        for (int it = blockIdx.x; it < SEQ / 16; it += F.G) filter_item(F, it);
        { const size_t nchunk = (size_t)M * DM / 8; const f32x4* x4 = (const f32x4*)F.x; u32x4* xo = (u32x4*)F.xb;
          for (size_t ch = (size_t)blockIdx.x * NTHR + F.tid; ch < nchunk; ch += (size_t)F.G * NTHR) { const f32x4 a = x4[2 * ch], b = x4[2 * ch + 1]; u32x4 o; o.x = pk2(a.x, a.y); o.y = pk2(a.z, a.w); o.z = pk2(b.x, b.y); o.w = pk2(b.z, b.w); xo[ch] = o; } }
    }
    SEAM(0);
    if (IN(1)) REP(1) {
        pg8::Gemm g{F.xb, F.WinT, M, INC, DM}; pg8::StaticOrder S; S.init(M, INC, F.G, (int)blockIdx.x);
        pg8::EpiBf16<0> E{F.proj, INC, 1024, QSCALE};
        pg8::gemm_phase<pg8::EpiBf16<0>, pg8::StaticOrder, true, true>(F.lds, g, S, E);
    }
    SEAM(1);
    if (IN(2)) REP(2) { for (int it = blockIdx.x; it < 4096; it += F.G) h1_item(F, it); }
    SEAM(2);
    if (IN(3)) REP(3) {
        float sa = F.lq1[F.lane] * F.lk1[F.lane], sb = F.lq2[F.lane] * F.lk2[F.lane]; sa = wave_sum(sa); sb = wave_sum(sb);
        const float lam = __expf(sa) - __expf(sb) + 0.2f;
#ifndef REP_ATT
#define REP_ATT 1
#endif
#ifndef REP_HY
#define REP_HY 1
#endif
#ifndef NO_ATT
        for (int ra_ = 0; ra_ < REP_ATT; ++ra_) for (int u = F.vcu; u < 1024; u += F.G) att::attn_unit(F.lds, F.proj, F.mix, u >> 7, (u >> 4) & 7, u & 15, lam, F.subg);
#endif
#ifndef NO_HY
        for (int rh_ = 0; rh_ < REP_HY; ++rh_) for (int c = F.vcu; c < NCH; c += F.G) hy::conv_unit(F.lds, c, F.filt, F.vgT, F.x1T, F.yT, F.hskip);
#endif
    }
    SEAM(3);
    if (IN(4)) REP(4) { for (int it = blockIdx.x; it < 512; it += F.G) h3_item(F, it); }
    SEAM(4);
    if (IN(5)) REP(5) {
        pg8::Gemm g{F.mix, F.WoutT, M, DM, DM}; pg8::StaticOrder S; S.init(M, DM, F.G, (int)blockIdx.x);
        pg8::EpiResF32 E{F.x, F.out, DM, ALPHA};
        pg8::gemm_phase<pg8::EpiResF32, pg8::StaticOrder, true, true>(F.lds, g, S, E);
    }
    SEAM(5);
    if (IN(6)) ln_rows(F, F.out, F.ln1g, F.ln1b, F.x1b);
    SEAM(6);
    if (IN(7)) REP(7) {
        pg8::Gemm g{F.x1b, F.Wff1T, M, DFF, DM}; pg8::StaticOrder S; S.init(M, DFF, F.G, (int)blockIdx.x);
        pg8::EpiBf16<2> E{F.hbuf, DFF, 0, 1.f};
        pg8::gemm_phase<pg8::EpiBf16<2>, pg8::StaticOrder, true, true>(F.lds, g, S, E);
    }
    SEAM(7);
    if (IN(8)) {
        pg8::Gemm g{F.hbuf, F.Wff2T, M, DM, DFF}; pg8::StaticOrder S; S.init(M, DM, F.G, (int)blockIdx.x);
        pg8::EpiResF32 E{F.out, F.out, DM, ALPHA};
        pg8::gemm_phase<pg8::EpiResF32, pg8::StaticOrder, true, true>(F.lds, g, S, E);
    }
    SEAM(8);
    if (IN(9)) ln_rows(F, F.out, F.ln2g, F.ln2b, nullptr);
#undef IN
#undef SEAM
}

#ifndef MK_N_LAUNCHES
#define MK_N_LAUNCHES 1
#endif
extern "C" void kernel_launch(void* const* d_in, const int* in_sizes, int n_in, void* d_out, int out_size, void* d_ws, size_t ws_size, hipStream_t stream) {
    static int grid = 0;
    if (grid == 0) {
        if (n_in != 24 || in_sizes[0] != M * DM || out_size != M * DM || ws_size < WS_END) { fprintf(stderr, "kernel_launch: unexpected problem shape (n_in %d, in0 %d, out %d, ws %zu); nothing launched\n", n_in, n_in > 0 ? in_sizes[0] : -1, out_size, ws_size); grid = -1; return; }
        int dev = 0, cus = 0, per_cu = 0;
        if (hipGetDevice(&dev) != hipSuccess || hipDeviceGetAttribute(&cus, hipDeviceAttributeMultiprocessorCount, dev) != hipSuccess) { grid = -1; return; }
        if (hipFuncSetAttribute((const void*)hymba_fwd, hipFuncAttributeMaxDynamicSharedMemorySize, LDS_BYTES) != hipSuccess) { fprintf(stderr, "kernel_launch: hipFuncSetAttribute failed\n"); grid = -1; return; }
        if (hipOccupancyMaxActiveBlocksPerMultiprocessor(&per_cu, (const void*)hymba_fwd, NTHR, LDS_BYTES) != hipSuccess || per_cu < 1) { fprintf(stderr, "kernel_launch: occupancy query says %d blocks per CU\n", per_cu); per_cu = 1; }
        (void)hipGetLastError();
        grid = cus * per_cu;
    }
    if (grid < 0) return;
    Args a{};
    for (int i = 0; i < 24; ++i) a.in[i] = (const float*)d_in[i];
    a.out = (float*)d_out; a.ws = (unsigned char*)d_ws;
#if MK_N_LAUNCHES == 1
    a.ph_lo = 0; a.ph_hi = N_PHASES;
    void* kargs[] = {&a};
    const hipError_t e = hipLaunchCooperativeKernel((const void*)hymba_fwd, dim3(grid), dim3(NTHR), kargs, LDS_BYTES, stream);
    if (e != hipSuccess) fprintf(stderr, "kernel_launch: cooperative launch failed: %s (grid %d)\n", hipGetErrorString(e), grid);
#else
    for (int p = 0; p < N_PHASES; ++p) { a.ph_lo = p; a.ph_hi = p + 1; hipLaunchKernelGGL(hymba_fwd, dim3(grid), dim3(NTHR), LDS_BYTES, stream, a); }
#endif
}
```

```cpp
#include <hip/hip_runtime.h>
#include <hip/hip_cooperative_groups.h>
#include <cstdio>
#include <cstdint>
namespace cg = cooperative_groups;
namespace pg8 {
#define PG8_LAS __attribute__((address_space(3)))
typedef unsigned short bf16_t;
typedef short bf16x8 __attribute__((ext_vector_type(8)));
typedef float f32x4 __attribute__((ext_vector_type(4)));
typedef unsigned u32x4 __attribute__((ext_vector_type(4)));
constexpr int BM = 256, BK = 64, HALF = 128, HTB = HALF * BK * 2  , STAGE_BYTES = 8 * HTB, NXCD = 8, WGM = 8;

__host__ __device__ __forceinline__ int lds_byte(int r, int c) { const int st = (r >> 4) * 2 + (c >> 5), rr = r & 15, cc = c & 31, ob = rr * 64 + cc * 2; return st * 1024 + (ob ^ (((ob >> 9) & 1) << 5)); }
__host__ __device__ __forceinline__ void stage_rc(int b, int& R, int& C) { const int st = b / 1024, sb = b % 1024, swz = sb ^ (((sb >> 9) & 1) << 5); R = (st >> 1) * 16 + swz / 64; C = (st & 1) * 32 + (swz % 64) / 2; }
__host__ __device__ __forceinline__ int perm32(int rho) { const int n = rho >> 4, i = rho & 15; return 8 * (i >> 2) + 4 * n + (i & 3); }

struct Unit { int pm, pn; };
struct Gemm { const bf16_t* A; const bf16_t* Bt; int M, N, K; };

struct StaticOrder {
    int nM, nN, nwg, G, c;
    __host__ __device__ void init(int M, int N, int G_, int c_) { nM = M / BM; nN = N / BM; nwg = nM * nN; G = G_; c = c_; }
    __host__ __device__ bool next(int i, Unit& u) const {
        const long L = (long)i * G + c; if (L >= nwg) return false;
        int wgid = (int)L; { const int q = nwg / NXCD, r = nwg % NXCD, xcd = wgid % NXCD, off = wgid / NXCD; wgid = (xcd < r ? xcd * (q + 1) : r * (q + 1) + (xcd - r) * q) + off; }
        const int nig = WGM * nN, gid = wgid / nig, fm = gid * WGM, gsz = (nM - fm) < WGM ? (nM - fm) : WGM;
        u.pm = fm + ((wgid % nig) % gsz); u.pn = (wgid % nig) / gsz; return true;
    }
    __device__ __forceinline__ void a_ready(const Unit&) const {}
    __device__ __forceinline__ void done(const Unit&) const {}
};

__device__ __forceinline__ unsigned cvt_pk_bf16(float lo, float hi) { unsigned r; asm volatile("v_cvt_pk_bf16_f32 %0, %1, %2" : "=v"(r) : "v"(lo), "v"(hi)); return r; }
typedef float f32x2 __attribute__((ext_vector_type(2)));
template <int ACT> struct EpiBf16 {
    static constexpr bool PERM = true, AFTER_DRAIN = false;
    bf16_t* O; int ldc; int scale_cols; float scale0;
    __device__ __forceinline__ void operator()(const f32x4 (&acc)[2][2][4][2], const Unit& u, int wr, int wc, int fr, int fq) const {
        const int row0 = u.pm * BM + wr * 64 + fr; const int colt = u.pn * BM;
        const float sc = (colt < scale_cols) ? scale0 : 1.f;
        const int col0 = colt + wc * 32 + 8 * fq;
#pragma unroll
        for (int ai = 0; ai < 2; ++ai)
#pragma unroll
            for (int m = 0; m < 4; ++m) { bf16_t* rowp = O + (size_t)(row0 + ai * HALF + m * 16) * ldc + col0;
#pragma unroll
                for (int bj = 0; bj < 2; ++bj) { f32x4 v0 = acc[ai][bj][m][0], v1 = acc[ai][bj][m][1];
                    if (ACT == 2) {
#pragma unroll
                        for (int e = 0; e < 4; ++e) { const float a = v0[e] > 0.f ? v0[e] : 0.f, b = v1[e] > 0.f ? v1[e] : 0.f; v0[e] = a * a; v1[e] = b * b; } }
                    v0 = v0 * sc; v1 = v1 * sc; u32x4 w; w.x = cvt_pk_bf16(v0[0], v0[1]); w.y = cvt_pk_bf16(v0[2], v0[3]); w.z = cvt_pk_bf16(v1[0], v1[1]); w.w = cvt_pk_bf16(v1[2], v1[3]);
                    *(u32x4*)(rowp + bj * HALF) = w; } }
    }
};
struct EpiResF32 {
    static constexpr bool PERM = false, AFTER_DRAIN = false;
    const float* base; float* out; int ldc; float alpha;
    __device__ __forceinline__ void operator()(const f32x4 (&acc)[2][2][4][2], const Unit& u, int wr, int wc, int fr, int fq) const {
        const int col0 = u.pn * BM + wc * 32 + 4 * fq;
#pragma unroll
        for (int ai = 0; ai < 2; ++ai)
#pragma unroll
            for (int m = 0; m < 4; ++m) { const size_t off = (size_t)(u.pm * BM + ai * HALF + wr * 64 + m * 16 + fr) * ldc + col0;
#pragma unroll
                for (int bj = 0; bj < 2; ++bj)
#pragma unroll
                    for (int n = 0; n < 2; ++n) { const f32x4 bs = *(const f32x4*)(base + off + bj * HALF + n * 16); const f32x4 o = bs * alpha + acc[ai][bj][m][n]; *(f32x4*)(out + off + bj * HALF + n * 16) = o; }
                asm volatile("" ::: "memory"); }
    }
};
template <class Epi, class Sched, bool ALIGN_EPI = false, bool SP2 = false>
__device__ __forceinline__ void gemm_phase(PG8_LAS unsigned char* lds, const Gemm g, const Sched& S, const Epi& E) {
    const int tid = threadIdx.x, wid = __builtin_amdgcn_readfirstlane(tid >> 6), lane = tid & 63, wr = wid >> 2, wc = wid & 3, fr = lane & 15, fq = lane >> 4;
    const int K = g.K, nt = K / BK;
    unsigned voffA[2], voffB[2];
#pragma unroll
    for (int i = 0; i < 2; ++i) { int R, C; stage_rc(tid * 16 + i * 8192, R, C); const int Rb = Epi::PERM ? ((R & ~31) + perm32(R & 31)) : R;
        voffA[i] = (unsigned)(R * K + C) * 2u; voffB[i] = (unsigned)(Rb * K + C) * 2u; }
    const size_t kstep = (size_t)(BK * 2);
    const size_t hstep = (size_t)HALF * K * 2;
    const size_t tstep = 2 * hstep;
    const unsigned ldsw = (unsigned)wid * 1024u;
    const int aoff = lds_byte(wr * 64 + fr, fq * 8), boff = lds_byte(wc * 32 + fr, fq * 8);
#define PG8_SA(b, h) (((b) * 2 + (h)) * HTB)
#define PG8_SB(b, h) ((4 + (b) * 2 + (h)) * HTB)
#define PG8_STAGE(bufoff, gbase, voff) do { _Pragma("unroll") for (int _i = 0; _i < 2; ++_i) \
        __builtin_amdgcn_global_load_lds((const unsigned*)((const char*)(gbase) + (voff)[_i]), (PG8_LAS unsigned*)(lds + (bufoff) + ldsw + _i * 8192), 16, 0, 0); } while (0)
#define PG8_LDA(dst, b, h) do { _Pragma("unroll") for (int m = 0; m < 4; ++m) _Pragma("unroll") for (int k = 0; k < 2; ++k) dst[m][k] = *(const PG8_LAS bf16x8*)(lds + PG8_SA(b, h) + aoff + m * 2048 + k * 1024); } while (0)
#define PG8_LDB(dst, b, h) do { _Pragma("unroll") for (int n = 0; n < 2; ++n) _Pragma("unroll") for (int k = 0; k < 2; ++k) dst[n][k] = *(const PG8_LAS bf16x8*)(lds + PG8_SB(b, h) + boff + n * 2048 + k * 1024); } while (0)
#define PG8_MMA(ai, bj, At, Bt) do { __builtin_amdgcn_s_setprio(1); _Pragma("unroll") for (int m = 0; m < 4; ++m) _Pragma("unroll") for (int n = 0; n < 2; ++n) _Pragma("unroll") for (int k = 0; k < 2; ++k) \
        acc[ai][bj][m][n] = __builtin_amdgcn_mfma_f32_16x16x32_bf16(Bt[n][k], At[m][k], acc[ai][bj][m][n], 0, 0, 0); __builtin_amdgcn_s_setprio(0); } while (0)
#define PG8_WAIT_V(n) asm volatile("s_waitcnt vmcnt(" #n ")" ::: "memory")
#define PG8_WAIT_L(n) asm volatile("s_waitcnt lgkmcnt(" #n ")" ::: "memory")
#define PG8_BAR __builtin_amdgcn_s_barrier()
#define PG8_SCHED __builtin_amdgcn_sched_barrier(0)
    Unit cur, nxt; int ui = 0;
    if (!S.next(0, cur)) return;
    f32x4 acc[2][2][4][2];
#pragma unroll
    for (int a = 0; a < 2; ++a)
#pragma unroll
        for (int b = 0; b < 2; ++b)
#pragma unroll
            for (int m = 0; m < 4; ++m)
#pragma unroll
                for (int n = 0; n < 2; ++n) acc[a][b][m][n] = (f32x4){0.f, 0.f, 0.f, 0.f};
    bf16x8 At[4][2], B0[2][2], B1[2][2];
    const char* cA = (const char*)g.A + (size_t)cur.pm * tstep; const char* cB = (const char*)g.Bt + (size_t)cur.pn * tstep;
    S.a_ready(cur);
    if constexpr (SP2) {
        PG8_STAGE(PG8_SB(0, 0), cB, voffB); PG8_STAGE(PG8_SB(0, 1), cB + hstep, voffB); PG8_STAGE(PG8_SA(0, 0), cA, voffA); PG8_STAGE(PG8_SA(0, 1), cA + hstep, voffA);
        if (wr == 1) PG8_BAR;
        PG8_WAIT_V(2); PG8_BAR;
        PG8_STAGE(PG8_SB(1, 0), cB + kstep, voffB); PG8_STAGE(PG8_SA(1, 0), cA + kstep, voffA); PG8_STAGE(PG8_SB(1, 1), cB + hstep + kstep, voffB);
        PG8_WAIT_V(6); PG8_BAR;
    } else {
        PG8_STAGE(PG8_SB(0, 0), cB, voffB); PG8_STAGE(PG8_SA(0, 0), cA, voffA); PG8_STAGE(PG8_SB(0, 1), cB + hstep, voffB); PG8_STAGE(PG8_SA(0, 1), cA + hstep, voffA);
        if (wr == 1) PG8_BAR;
        PG8_WAIT_V(4); PG8_BAR;
        PG8_STAGE(PG8_SB(1, 0), cB + kstep, voffB); PG8_STAGE(PG8_SA(1, 0), cA + kstep, voffA); PG8_STAGE(PG8_SB(1, 1), cB + hstep + kstep, voffB);
        PG8_WAIT_V(6); PG8_BAR;
    }
    for (;;) {
        const bool has_next = S.next(ui + 1, nxt);
        const char* nA = has_next ? (const char*)g.A + (size_t)nxt.pm * tstep : cA; const char* nB = has_next ? (const char*)g.Bt + (size_t)nxt.pn * tstep : cB;
        for (int t = 0; t < nt; t += 2) {
            const bool last = (t == nt - 2);
            const char* a1 = cA + (size_t)(t + 1) * kstep;
            const char* a2 = last ? nA : cA + (size_t)(t + 2) * kstep; const char* b2 = last ? nB : cB + (size_t)(t + 2) * kstep;
            const char* a3 = a2 + kstep; const char* b3 = b2 + kstep;
            if (last && has_next) S.a_ready(nxt);
            if constexpr (SP2) {
            PG8_LDB(B0, 0, 0); PG8_LDB(B1, 0, 1); PG8_SCHED; PG8_LDA(At, 0, 0); PG8_STAGE(PG8_SA(1, 1), a1 + hstep, voffA);
            PG8_WAIT_V(8); PG8_WAIT_L(0); PG8_BAR; PG8_MMA(0, 0, At, B0); PG8_MMA(0, 1, At, B1); PG8_BAR; PG8_SCHED;
            PG8_LDA(At, 0, 1); PG8_STAGE(PG8_SB(0, 0), b2, voffB); PG8_STAGE(PG8_SB(0, 1), b2 + hstep, voffB); PG8_STAGE(PG8_SA(0, 0), a2, voffA);
            PG8_WAIT_V(8); PG8_WAIT_L(0); PG8_BAR; PG8_MMA(1, 0, At, B0); PG8_MMA(1, 1, At, B1); PG8_BAR; PG8_SCHED;
            PG8_LDB(B0, 1, 0); PG8_LDB(B1, 1, 1); PG8_SCHED; PG8_LDA(At, 1, 0); PG8_STAGE(PG8_SA(0, 1), a2 + hstep, voffA);
            PG8_WAIT_V(8); PG8_WAIT_L(0); PG8_BAR; PG8_MMA(0, 0, At, B0); PG8_MMA(0, 1, At, B1); PG8_BAR; PG8_SCHED;
            PG8_LDA(At, 1, 1); PG8_STAGE(PG8_SB(1, 0), b3, voffB); PG8_STAGE(PG8_SB(1, 1), b3 + hstep, voffB); PG8_STAGE(PG8_SA(1, 0), a3, voffA);
            PG8_WAIT_V(8); PG8_WAIT_L(0); PG8_BAR; PG8_MMA(1, 0, At, B0); PG8_MMA(1, 1, At, B1); PG8_BAR; PG8_SCHED;
            } else {
            PG8_LDB(B0, 0, 0); PG8_SCHED; PG8_LDA(At, 0, 0); PG8_STAGE(PG8_SA(1, 1), a1 + hstep, voffA);
            PG8_WAIT_L(8); PG8_BAR; PG8_WAIT_L(0); PG8_MMA(0, 0, At, B0); PG8_BAR; PG8_SCHED;
            PG8_LDB(B1, 0, 1); PG8_STAGE(PG8_SB(0, 0), b2, voffB);
            PG8_BAR; PG8_WAIT_L(0); PG8_MMA(0, 1, At, B1); PG8_BAR;
            PG8_LDA(At, 0, 1); PG8_STAGE(PG8_SA(0, 0), a2, voffA);
            PG8_BAR; PG8_WAIT_L(0); PG8_MMA(1, 0, At, B0); PG8_BAR; PG8_SCHED;
            PG8_STAGE(PG8_SB(0, 1), b2 + hstep, voffB);
            PG8_WAIT_V(6); PG8_BAR; PG8_MMA(1, 1, At, B1); PG8_BAR;
            PG8_LDB(B0, 1, 0); PG8_SCHED; PG8_LDA(At, 1, 0); PG8_STAGE(PG8_SA(0, 1), a2 + hstep, voffA);
            PG8_WAIT_L(8); PG8_BAR; PG8_WAIT_L(0); PG8_MMA(0, 0, At, B0); PG8_BAR; PG8_SCHED;
            PG8_LDB(B1, 1, 1); PG8_STAGE(PG8_SB(1, 0), b3, voffB);
            PG8_BAR; PG8_WAIT_L(0); PG8_MMA(0, 1, At, B1); PG8_BAR;
            PG8_LDA(At, 1, 1); PG8_STAGE(PG8_SA(1, 0), a3, voffA);
            PG8_BAR; PG8_WAIT_L(0); PG8_MMA(1, 0, At, B0); PG8_BAR; PG8_SCHED;
            PG8_STAGE(PG8_SB(1, 1), b3 + hstep, voffB);
            PG8_WAIT_V(6); PG8_BAR; PG8_MMA(1, 1, At, B1); PG8_BAR;
            }
        }
        if constexpr (ALIGN_EPI) { if (wr == 0) PG8_BAR; }
        if constexpr (!Epi::AFTER_DRAIN) { E(acc, cur, wr, wc, fr, fq); S.done(cur); }
        if (!has_next) break;
#pragma unroll
        for (int a = 0; a < 2; ++a)
#pragma unroll
            for (int b = 0; b < 2; ++b)
#pragma unroll
                for (int m = 0; m < 4; ++m)
#pragma unroll
                    for (int n = 0; n < 2; ++n) acc[a][b][m][n] = (f32x4){0.f, 0.f, 0.f, 0.f};
        cur = nxt; cA = nA; cB = nB; ++ui;
        if constexpr (ALIGN_EPI) { if (wr == 1) PG8_BAR; }
    }
    PG8_WAIT_V(0);
    if constexpr (!ALIGN_EPI) { if (wr == 0) PG8_BAR; }
    PG8_BAR;
    if constexpr (Epi::AFTER_DRAIN) { E.fused(acc, cur, wr, wc, fr, fq, lds, wid, lane); S.done(cur); }
#undef PG8_SA
#undef PG8_SB
#undef PG8_STAGE
#undef PG8_LDA
#undef PG8_LDB
#undef PG8_MMA
#undef PG8_WAIT_V
#undef PG8_WAIT_L
#undef PG8_BAR
#undef PG8_SCHED
}
}
#define LAS __attribute__((address_space(3)))
typedef pg8::bf16_t bf16;
typedef unsigned u32x4 __attribute__((ext_vector_type(4)));
typedef unsigned u32x2 __attribute__((ext_vector_type(2)));
typedef float f32x4 __attribute__((ext_vector_type(4)));
typedef float f32x16 __attribute__((ext_vector_type(16)));
typedef short bf16x8 __attribute__((ext_vector_type(8)));
typedef short s16x4 __attribute__((ext_vector_type(4)));
constexpr int NWAVES = 8, NTHR = 512;
constexpr int DM = 2048, BATCH = 8, SEQ = 2048, M = BATCH * SEQ, INC = 6144, DFF = 8192, NCH = 1024;
constexpr float ALPHA = 1.189207115002721f;
constexpr float LN_EPS = 1e-5f, LOG2E = 1.4426950408889634f, QSCALE = 0.125f * LOG2E;
constexpr size_t MiB = 1u << 20;
constexpr size_t WS_WIN = 1 * MiB, WS_WOUT = 25 * MiB, WS_WFF1 = 33 * MiB, WS_WFF2 = 65 * MiB;
constexpr size_t WS_XB = 97 * MiB;
constexpr size_t WS_PROJ = 161 * MiB;
constexpr size_t WS_X1B = 353 * MiB;
constexpr size_t WS_YT = 353 * MiB, WS_VGT = 417 * MiB, WS_X1T = 449 * MiB, WS_FILT = 481 * MiB;
constexpr size_t WS_H = 97 * MiB;
constexpr size_t WS_END = 489 * MiB;
constexpr size_t WS_CTL = 0, CTL_ZERO_BYTES = 65536;
constexpr int LDS_STAGE_BYTES = 131072, LDS_BYTES = LDS_STAGE_BYTES + 256;

__device__ __forceinline__ unsigned pk2(float lo, float hi) { return pg8::cvt_pk_bf16(lo, hi); }
__device__ __forceinline__ unsigned short f2bf(float f) { unsigned u = __builtin_bit_cast(unsigned, f); return (unsigned short)((u + 0x7fffu + ((u >> 16) & 1u)) >> 16); }
__device__ __forceinline__ float bflo(unsigned w) { return __uint_as_float(w << 16); }
__device__ __forceinline__ float bfhi(unsigned w) { return __uint_as_float(w & 0xffff0000u); }
__device__ __forceinline__ float wave_sum(float v) {
#pragma unroll
    for (int o = 1; o < 64; o <<= 1) v += __shfl_xor(v, o);
    return v;
}
__device__ __forceinline__ float half_swap_max(float v) { auto rr = __builtin_amdgcn_permlane32_swap(__float_as_uint(v), __float_as_uint(v), false, false); return fmaxf(__uint_as_float(rr[0]), __uint_as_float(rr[1])); }
__device__ __forceinline__ float half_swap_sum(float v) { auto rr = __builtin_amdgcn_permlane32_swap(__float_as_uint(v), __float_as_uint(v), false, false); return __uint_as_float(rr[0]) + __uint_as_float(rr[1]); }

struct Frame {
    LAS unsigned char* lds;
    int tid, lane, wave, vcu, G;
    const float *x, *w_in, *lq1, *lk1, *lq2, *lk2, *subg, *conv_w, *conv_b, *fw1, *fb1, *ffreq, *fw2, *fb2, *fw3, *hskip, *hgain, *w_out, *ln1g, *ln1b, *w_ff1, *w_ff2, *ln2g, *ln2b;
    float* out;
    bf16 *WinT, *WoutT, *Wff1T, *Wff2T, *xb, *mix, *proj, *x1b, *yT, *vgT, *x1T, *filt, *hbuf;
};

__device__ __forceinline__ void p0_transpose_item(const float* W, int K, int N, bf16* WT, LAS float* scr, int item, int lane) {
    const int nblk = N / 32, kb = item / nblk, nb = item % nblk, k0 = 64 * kb, n0 = 32 * nb;
#pragma unroll 8
    for (int i = 0; i < 32; ++i) { const int kk = 2 * i + (lane >> 5); scr[kk * 33 + (lane & 31)] = W[(size_t)(k0 + kk) * N + n0 + (lane & 31)]; }
    asm volatile("s_waitcnt lgkmcnt(0)" ::: "memory");
    const int c = lane & 7;
#pragma unroll
    for (int j = 0; j < 4; ++j) { const int n = (lane >> 3) + 8 * j; const LAS float* s = scr + (8 * c) * 33 + n;
        u32x4 o; o.x = pk2(s[0 * 33], s[1 * 33]); o.y = pk2(s[2 * 33], s[3 * 33]); o.z = pk2(s[4 * 33], s[5 * 33]); o.w = pk2(s[6 * 33], s[7 * 33]);
        *(u32x4*)(WT + (size_t)(n0 + n) * K + k0 + 8 * c) = o; }
    asm volatile("s_waitcnt lgkmcnt(0)" ::: "memory");
}
__device__ __forceinline__ void filter_item(Frame& F, int it) {
    LAS float* zs = (LAS float*)F.lds; LAS float* h1s = zs + 16 * 33; LAS float* h2s = h1s + 16 * 64;
    const int tid = F.tid, l0 = it * 16;
    for (int idx = tid; idx < 16 * 33; idx += NTHR) { const int r = idx / 33, e = idx - r * 33, l = l0 + r; float val;
        if (e == 0) val = (float)l / 2047.0f;
        else { const int j = (e - 1) & 15; const float f = 1e-4f + (float)j * ((15.0f - 1e-4f) / 15.0f); const float w = (6.283185307179586f * (float)l) / 2048.0f; const float a = f * w; val = (e <= 16) ? __cosf(a) : -__sinf(a); }
        zs[idx] = val; }
    __syncthreads();
    for (int idx = tid; idx < 1024; idx += NTHR) { const int r = idx >> 6, o = idx & 63; float a = F.fb1[o];
        for (int e = 0; e < 33; ++e) a += zs[r * 33 + e] * F.fw1[e * 64 + o];
        h1s[idx] = __sinf(F.ffreq[o] * a); }
    __syncthreads();
    for (int idx = tid; idx < 1024; idx += NTHR) { const int r = idx >> 6, o = idx & 63; float a = F.fb2[o];
        for (int e = 0; e < 64; ++e) a += h1s[r * 64 + e] * F.fw2[e * 64 + o];
        h2s[idx] = __sinf(F.ffreq[o] * a); }
    __syncthreads();
    const int n0 = tid * 4;
    f32x4 acc[16];
#pragma unroll
    for (int r = 0; r < 16; ++r) acc[r] = (f32x4){0.f, 0.f, 0.f, 0.f};
    for (int k = 0; k < 64; k += 4) {
        const f32x4 w0 = *(const f32x4*)(F.fw3 + (size_t)(k + 0) * 2048 + n0), w1 = *(const f32x4*)(F.fw3 + (size_t)(k + 1) * 2048 + n0),
                    w2 = *(const f32x4*)(F.fw3 + (size_t)(k + 2) * 2048 + n0), w3 = *(const f32x4*)(F.fw3 + (size_t)(k + 3) * 2048 + n0);
#pragma unroll
        for (int r = 0; r < 16; ++r) { const f32x4 hv = *(const LAS f32x4*)(h2s + r * 64 + k); acc[r] += w0 * hv.x + w1 * hv.y + w2 * hv.z + w3 * hv.w; }
    }
    const int ch0 = n0 & 1023; const bool fwd = n0 < 1024;
    const float DMIN = -3.0701134573253945f, DMAX = -15.350567286626972f;
#pragma unroll
    for (int e = 0; e < 4; ++e) { const int ch = ch0 + e; const float ad = fabsf(DMIN + (float)ch * ((DMAX - DMIN) / 1023.0f)); bf16* dst = F.filt + (size_t)ch * 4096;
#pragma unroll
        for (int r = 0; r < 16; ++r) { const int l = l0 + r; const float tl = (float)l / 2047.0f; const float val = acc[r][e] * __expf(-tl * ad);
            if (fwd) dst[2048 - l] = f2bf(val); else if (l >= 1) dst[2048 + l] = f2bf(val); }
        if (it == 0 && fwd) dst[0] = 0; }
    __syncthreads();
}
__device__ __forceinline__ void h1_item(Frame& F, int item) {
    const int cblk = item & 15, sblk = (item >> 4) & 31, b = item >> 9;
    const int tid = F.tid, s_l = tid >> 3, cg8 = tid & 7;
    const int s = sblk * 64 + s_l, c = cblk * 64 + cg8 * 8;
    const bf16* row = F.proj + ((size_t)(b * SEQ + s)) * INC + 3072 + c;
    float z[3][8];
#pragma unroll
    for (int a = 0; a < 3; ++a) { const bf16* p = row + a * 1024;
        u32x4 um = (u32x4){0u, 0u, 0u, 0u}, up = (u32x4){0u, 0u, 0u, 0u}; const u32x4 u0 = *(const u32x4*)p;
        if (s > 0) um = *(const u32x4*)(p - INC);
        if (s < SEQ - 1) up = *(const u32x4*)(p + INC);
        const float* cw = F.conv_w + a * 1024 + c; const float* cb = F.conv_b + a * 1024 + c;
#pragma unroll
        for (int e2 = 0; e2 < 4; ++e2) {
            const float m0 = bflo(um[e2]), m1 = bfhi(um[e2]), c0 = bflo(u0[e2]), c1 = bfhi(u0[e2]), p0 = bflo(up[e2]), p1 = bfhi(up[e2]);
            z[a][2 * e2]     = cb[2 * e2]     + m0 * cw[2 * e2]     + c0 * cw[3072 + 2 * e2]     + p0 * cw[6144 + 2 * e2];
            z[a][2 * e2 + 1] = cb[2 * e2 + 1] + m1 * cw[2 * e2 + 1] + c1 * cw[3072 + 2 * e2 + 1] + p1 * cw[6144 + 2 * e2 + 1]; } }
    LAS unsigned short* tv = (LAS unsigned short*)F.lds; LAS unsigned short* tx = tv + 64 * 66;
#pragma unroll
    for (int e = 0; e < 8; ++e) { tv[(cg8 * 8 + e) * 66 + s_l] = f2bf(z[2][e] * z[1][e]); tx[(cg8 * 8 + e) * 66 + s_l] = f2bf(z[0][e]); }
    __syncthreads();
    { const int c_l = tid >> 3, chunk = tid & 7;
      const LAS unsigned* pv = (const LAS unsigned*)(F.lds + c_l * 132 + chunk * 16); const LAS unsigned* px = (const LAS unsigned*)(F.lds + 64 * 132 + c_l * 132 + chunk * 16);
      u32x4 ov, ox; ov.x = pv[0]; ov.y = pv[1]; ov.z = pv[2]; ov.w = pv[3]; ox.x = px[0]; ox.y = px[1]; ox.z = px[2]; ox.w = px[3];
      const size_t go = ((size_t)((cblk * 64 + c_l) * 8 + b)) * 2048 + sblk * 64 + chunk * 8;
      *(u32x4*)(F.vgT + go) = ov; *(u32x4*)(F.x1T + go) = ox; }
    __syncthreads();
}
namespace att {
constexpr int KOFF = 0, VOFF = 32768, QOFF = 65536;
__device__ __forceinline__ int toff(int row, int ch) { return 256 * row + 16 * (ch ^ (((row & 3) << 2) | ((row >> 2) & 3))); }
#define MFMA32(a, b, c) __builtin_amdgcn_mfma_f32_32x32x16_bf16((a), (b), (c), 0, 0, 0)
__device__ __forceinline__ void glds16(const void* gsrc, unsigned lds_dst) { unsigned keep;
    asm volatile("s_mov_b32 %0, m0\n\ts_mov_b32 m0, %2\n\ts_nop 0\n\tglobal_load_lds_dwordx4 %1, off\n\ts_mov_b32 m0, %0" : "=&s"(keep) : "v"(gsrc), "s"(lds_dst) : "memory"); }
__device__ __forceinline__ float a_add(float a, float b) { float r; asm("v_add_f32_e32 %0, %1, %2" : "=v"(r) : "v"(a), "v"(b)); return r; }
__device__ __forceinline__ float a_sub(float a, float b) { float r; asm("v_sub_f32_e32 %0, %1, %2" : "=v"(r) : "v"(a), "v"(b)); return r; }
__device__ __forceinline__ float a_max3(float a, float b, float c) { float r; asm("v_max3_f32 %0, %1, %2, %3" : "=v"(r) : "v"(a), "v"(b), "v"(c)); return r; }
__device__ __forceinline__ float a_bias(float nsl2, float t, float negm) { float r; asm("v_fma_f32 %0, %1, |%2|, %3" : "=v"(r) : "v"(nsl2), "v"(t), "v"(negm)); return r; }
typedef float f32x2_t __attribute__((ext_vector_type(2))); typedef __bf16 bf16x2_t __attribute__((ext_vector_type(2)));
__device__ __forceinline__ unsigned cvtpk_m(float lo, float hi) { f32x2_t v = {lo, hi}; bf16x2_t b = __builtin_convertvector(v, bf16x2_t); return __builtin_bit_cast(unsigned, b); }
template <int K> __device__ __forceinline__ float a_subk(float b) { float r; asm("v_subrev_f32_e32 %0, %1, %2" : "=v"(r) : "n"(__builtin_bit_cast(int, (float)K)), "v"(b)); return r; }
#define ATT_WAIT_BAR(N) asm volatile("s_waitcnt vmcnt(" #N ") lgkmcnt(0)\n\ts_barrier" ::: "memory")
__device__ __forceinline__ s16x4 vtr(const LAS unsigned char* p) { return __builtin_bit_cast(s16x4, __builtin_amdgcn_ds_read_tr16_b64_v4i16((LAS s16x4*)p)); }

__device__ __forceinline__ void attn_unit(LAS unsigned char* lds, const bf16* proj, bf16* mix, int b, int h, int qb, float lam, const float* subg) {
    const int tid = threadIdx.x, lane = tid & 63, r32 = lane & 31, hi = lane >> 5;
    const int wid = __builtin_amdgcn_readfirstlane(tid >> 6);
    const int c = wid >> 2, qi = wid & 3; const bool grpB = (wid >= 4);
    const size_t rowbase = (size_t)b * SEQ;
    const int qpos = qb * 128 + qi * 32 + r32;
    constexpr int NT = SEQ / 64, SLOT = 32768, VO = 16384;
    bf16x8 qf[4];
    { const bf16* qg = proj + (rowbase + qpos) * INC + h * 128 + c * 64 + hi * 8;
#pragma unroll
      for (int d0 = 0; d0 < 4; ++d0) qf[d0] = *(const bf16x8*)(qg + d0 * 16); }
    const bf16* kvg = proj + rowbase * INC + 1024 + h * 128;
    size_t goff[2];
#pragma unroll
    for (int j = 0; j < 2; ++j) { const int row = 8 * wid + 4 * j + (lane >> 4); const int sw = ((lane >> 4) << 2) | ((2 * wid + j) & 3); goff[j] = (size_t)row * INC + 8 * ((lane & 15) ^ sw); }
    const unsigned lds0 = (unsigned)(uintptr_t)lds;
#define ATT_STAGE(t_, slot_) do { const int tt_ = (t_) < NT ? (t_) : NT - 1; const bf16* kt_ = kvg + (size_t)tt_ * 64 * INC; _Pragma("unroll") for (int j_ = 0; j_ < 2; ++j_) { \
        const unsigned d_ = (unsigned)__builtin_amdgcn_readfirstlane((int)(lds0 + (unsigned)((slot_) * SLOT + 256 * (8 * wid + 4 * j_)))); \
        glds16(kt_ + goff[j_], d_); glds16(kt_ + goff[j_] + 1024, d_ + VO); } } while (0)
    ATT_STAGE(0, 0); ATT_STAGE(1, 1);
    asm volatile("s_waitcnt vmcnt(0)" ::: "memory");
    __syncthreads();
    if (grpB) ATT_WAIT_BAR(0);
    const float sl2 = exp2f(-(float)(h + 1)) * LOG2E;
    const int swr = ((r32 & 3) << 2) | ((r32 >> 2) & 3);
    const LAS unsigned char* kbase = lds + 256 * r32;
    const int i16 = lane & 15, g1 = (lane >> 4) & 1;
    int vaddr[4][2];
#pragma unroll
    for (int db = 0; db < 4; ++db)
#pragma unroll
        for (int sec = 0; sec < 2; ++sec) { const int swv = ((i16 >> 2) << 2) | (hi + 2 * sec); const int ch = 4 * db + 2 * g1 + ((i16 & 3) >> 1);
            vaddr[db][sec] = VO + 256 * (4 * hi + (i16 >> 2) + 8 * sec) + 16 * (ch ^ swv) + 8 * (i16 & 1); }
    f32x16 o[4];
#pragma unroll
    for (int db = 0; db < 4; ++db)
#pragma unroll
        for (int i = 0; i < 16; ++i) o[db][i] = 0.f;
    float mref = 0.f, lsum = 0.f;
    int s0 = 0, s1 = 1, s2 = 2;
    for (int t = 0; t < NT; ++t) {
        if (grpB) ATT_STAGE(t + 2, s2);
        f32x16 p[2];
        const float nsl2 = -sl2, negm = -mref;
#pragma unroll
        for (int kh = 0; kh < 2; ++kh) {
            const float basef = (float)(qpos - 64 * t - 32 * kh - 4 * hi);
            f32x16 acc;
#define ATT_CI(i) acc[i] = a_bias(nsl2, a_subk<((i) & 3) + 8 * ((i) >> 2)>(basef), negm)
            ATT_CI(0); ATT_CI(1); ATT_CI(2); ATT_CI(3); ATT_CI(4); ATT_CI(5); ATT_CI(6); ATT_CI(7); ATT_CI(8); ATT_CI(9); ATT_CI(10); ATT_CI(11); ATT_CI(12); ATT_CI(13); ATT_CI(14); ATT_CI(15);
#undef ATT_CI
            asm volatile("s_nop 1" : "+v"(acc));
#pragma unroll
            for (int d0 = 0; d0 < 4; ++d0) { const int ch = c * 8 + d0 * 2 + hi;
                const bf16x8 kf = *(const LAS bf16x8*)(kbase + s0 * SLOT + kh * 8192 + 16 * (ch ^ swr));
                acc = MFMA32(kf, qf[d0], acc); }
            p[kh] = acc;
        }
        asm volatile("s_nop 15\n\ts_nop 7" : "+v"(p[0]), "+v"(p[1]));
        float rm;
        { float ra = a_max3(p[0][0], p[0][1], p[1][0]), rb = a_max3(p[0][2], p[0][3], p[1][1]); ra = a_max3(ra, p[1][2], p[1][3]);
#pragma unroll
          for (int i = 4; i < 16; i += 4) { ra = a_max3(ra, p[0][i], p[0][i + 1]); rb = a_max3(rb, p[0][i + 2], p[0][i + 3]); ra = a_max3(ra, p[1][i], p[1][i + 1]); rb = a_max3(rb, p[1][i + 2], p[1][i + 3]); }
          rm = fmaxf(ra, rb); }
        rm = half_swap_max(rm);
        if (t == 0 || __any(rm > 8.0f)) {
            const float delta = (t == 0) ? rm : fmaxf(rm, 0.f);
            mref += delta;
#pragma unroll
            for (int i = 0; i < 16; ++i) { p[0][i] = a_sub(p[0][i], delta); p[1][i] = a_sub(p[1][i], delta); }
            if (t != 0) { const float f = __builtin_amdgcn_exp2f(-delta); lsum *= f;
#pragma unroll
                for (int db = 0; db < 4; ++db) o[db] = o[db] * f; }
        }
        { float sa = 0.f, sb = 0.f;
#pragma unroll
          for (int i = 0; i < 16; ++i) { p[0][i] = __builtin_amdgcn_exp2f(p[0][i]); p[1][i] = __builtin_amdgcn_exp2f(p[1][i]); }
          asm volatile("s_nop 0" : "+v"(p[0]), "+v"(p[1]));
#pragma unroll
          for (int i = 0; i < 16; ++i) { sa = a_add(sa, p[0][i]); sb = a_add(sb, p[1][i]); }
          lsum = a_add(lsum, a_add(sa, sb)); }
        bf16x8 pfr[4];
#pragma unroll
        for (int kh = 0; kh < 2; ++kh)
#pragma unroll
            for (int sp = 0; sp < 2; ++sp) { u32x4 w; w.x = cvtpk_m(p[kh][8 * sp + 0], p[kh][8 * sp + 1]); w.y = cvtpk_m(p[kh][8 * sp + 2], p[kh][8 * sp + 3]); w.z = cvtpk_m(p[kh][8 * sp + 4], p[kh][8 * sp + 5]); w.w = cvtpk_m(p[kh][8 * sp + 6], p[kh][8 * sp + 7]);
                pfr[2 * kh + sp] = __builtin_bit_cast(bf16x8, w); }
        ATT_WAIT_BAR(4);
        if (!grpB) ATT_STAGE(t + 2, s2);
#pragma unroll
        for (int db = 0; db < 4; ++db)
#pragma unroll
            for (int s = 0; s < 4; ++s) { const LAS unsigned char* vb = lds + s0 * SLOT + 4096 * s;
                const s16x4 lo = vtr(vb + vaddr[db][0]), hi4 = vtr(vb + vaddr[db][1]);
                const bf16x8 vf = (bf16x8){lo[0], lo[1], lo[2], lo[3], hi4[0], hi4[1], hi4[2], hi4[3]};
                o[db] = MFMA32(vf, pfr[s], o[db]); }
        ATT_WAIT_BAR(4);
        { const int tmp = s0; s0 = s1; s1 = s2; s2 = tmp; }
    }
    if (!grpB) ATT_WAIT_BAR(0);
    asm volatile("s_waitcnt vmcnt(0)" ::: "memory");
    __syncthreads();
    const float lt = half_swap_sum(lsum);
    LAS float* xch = (LAS float*)(lds + qi * 16384) + lane;
    if (c == 1) { const float inv = lam / lt;
#pragma unroll
        for (int db = 0; db < 4; ++db)
#pragma unroll
            for (int i = 0; i < 16; ++i) xch[(db * 16 + i) * 64] = o[db][i] * inv; }
    __syncthreads();
    if (c == 0) {
        const float inv = 1.0f / lt; float ss = 0.f;
#pragma unroll
        for (int db = 0; db < 4; ++db)
#pragma unroll
            for (int i = 0; i < 16; ++i) { const float v = o[db][i] * inv - xch[(db * 16 + i) * 64]; o[db][i] = v; ss += v * v; }
        ss = half_swap_sum(ss);
        const float rstd = (1.0f / sqrtf(ss * (1.0f / 128.0f) + LN_EPS)) * 0.8f;
        bf16* orow = mix + (rowbase + qpos) * DM + h * 128;
#pragma unroll
        for (int db = 0; db < 4; ++db)
#pragma unroll
            for (int g = 0; g < 4; ++g) { const int d = 32 * db + 8 * g + 4 * hi; const f32x4 gg = *(const f32x4*)(subg + d);
                u32x2 w; w.x = pk2(o[db][4 * g] * rstd * gg.x, o[db][4 * g + 1] * rstd * gg.y); w.y = pk2(o[db][4 * g + 2] * rstd * gg.z, o[db][4 * g + 3] * rstd * gg.w);
                *(u32x2*)(orow + d) = w; }
    }
    __syncthreads();
}
#undef ATT_STAGE
}

namespace hy {
constexpr int CPS = 8224, VGO = 8 * CPS, VGS = 4112, RSTG = VGO + 8 * VGS;
#define MFMA16(a, b, c) __builtin_amdgcn_mfma_f32_16x16x32_bf16((a), (b), (c), 0, 0, 0)
__device__ __forceinline__ void conv_unit(LAS unsigned char* lds, int c, const bf16* filt, const bf16* vgT, const bf16* x1T, bf16* yT, const float* dskip) {
    const int tid = threadIdx.x, lane = tid & 63; const int wid = __builtin_amdgcn_readfirstlane(tid >> 6);
    *(LAS u32x4*)(lds + RSTG + tid * 16) = *(const u32x4*)(filt + (size_t)c * 4096 + tid * 8);
#pragma unroll
    for (int k = 0; k < 4; ++k) { const int id = tid + 512 * k, bb = id >> 8, ch = id & 255; *(LAS u32x4*)(lds + VGO + bb * VGS + ch * 16) = *(const u32x4*)(vgT + ((size_t)(c * 8 + bb)) * 2048 + ch * 8); }
    __syncthreads();
    { const LAS unsigned short* R = (const LAS unsigned short*)(lds + RSTG);
      for (int id = tid; id < 8 * 513; id += NTHR) { const int sh = id / 513, m = id - sh * 513; const int n0 = 8 * m - sh; unsigned w[4];
#pragma unroll
          for (int jj = 0; jj < 4; ++jj) { const int na = n0 + 2 * jj, nb = na + 1; const unsigned lo = (na >= 0 && na < 4096) ? (unsigned)R[na] : 0u; const unsigned hi = (nb >= 0 && nb < 4096) ? (unsigned)R[nb] : 0u; w[jj] = lo | (hi << 16); }
          *(LAS u32x4*)(lds + sh * CPS + m * 16) = (u32x4){w[0], w[1], w[2], w[3]}; } }
    __syncthreads();
    const int i = lane & 15, kq = lane >> 4;
    f32x4 acc[16];
#pragma unroll
    for (int a = 0; a < 16; ++a) acc[a] = (f32x4){0.f, 0.f, 0.f, 0.f};
    const LAS unsigned char* abase = lds + (i & 7) * CPS + 16 * (256 - 32 * wid - (i >> 3) + kq - 30);
    const LAS unsigned char* bbase = lds + VGO + (i & 7) * VGS + 16 * kq;
    for (int sc = 0; sc < 4; ++sc) {
        bf16x8 bfr[16];
#pragma unroll
        for (int ci = 0; ci < 16; ++ci) bfr[ci] = *(const LAS bf16x8*)(bbase + 64 * (16 * sc + ci));
        const LAS unsigned char* ab = abase + 1024 * sc;
#pragma unroll
        for (int vv = 0; vv < 46; ++vv) {
            const bf16x8 af = *(const LAS bf16x8*)(ab + 32 * vv);
#pragma unroll
            for (int ci = 0; ci < 16; ++ci) { const int ai = 2 * ci - (vv - 15); if (ai >= 0 && ai < 16) acc[ai] = MFMA16(af, bfr[ci], acc[ai]); }
        }
    }
    if (i < 8) {
        const float dsk = dskip[c];
#pragma unroll
        for (int ai = 0; ai < 16; ++ai) { const int t = 16 * (16 * wid + ai) + 4 * kq;
            const u32x2 vg = *(const LAS u32x2*)(lds + VGO + i * VGS + 2 * t); const u32x2 x1 = *(const u32x2*)(x1T + ((size_t)(c * 8 + i)) * 2048 + t);
            const float y0 = (acc[ai][0] + bflo(vg.x) * dsk) * bflo(x1.x), y1 = (acc[ai][1] + bfhi(vg.x) * dsk) * bfhi(x1.x), y2 = (acc[ai][2] + bflo(vg.y) * dsk) * bflo(x1.y), y3 = (acc[ai][3] + bfhi(vg.y) * dsk) * bfhi(x1.y);
            u32x2 w; w.x = pk2(y0, y1); w.y = pk2(y2, y3); *(u32x2*)(yT + ((size_t)(c * 8 + i)) * 2048 + t) = w; }
    }
    __syncthreads();
}
}

__device__ __forceinline__ void h3_item(Frame& F, int item) {
    constexpr int RS = 2064;
    const int b = item >> 6, t0 = (item & 63) * 32, tid = F.tid;
#pragma unroll
    for (int k = 0; k < 8; ++k) { const int id = tid + 512 * k, c = id >> 2, chunk = id & 3;
        const u32x4 v = *(const u32x4*)(F.yT + ((size_t)(c * 8 + b)) * 2048 + t0 + chunk * 8);
        LAS unsigned char* base = F.lds + (chunk * 8) * RS + c * 2;
        *(LAS unsigned short*)(base + 0 * RS) = (unsigned short)(v.x & 0xffffu); *(LAS unsigned short*)(base + 1 * RS) = (unsigned short)(v.x >> 16);
        *(LAS unsigned short*)(base + 2 * RS) = (unsigned short)(v.y & 0xffffu); *(LAS unsigned short*)(base + 3 * RS) = (unsigned short)(v.y >> 16);
        *(LAS unsigned short*)(base + 4 * RS) = (unsigned short)(v.z & 0xffffu); *(LAS unsigned short*)(base + 5 * RS) = (unsigned short)(v.z >> 16);
        *(LAS unsigned short*)(base + 6 * RS) = (unsigned short)(v.w & 0xffffu); *(LAS unsigned short*)(base + 7 * RS) = (unsigned short)(v.w >> 16); }
    __syncthreads();
    const int t_l = tid >> 4, cgp = tid & 15;
    u32x4 d[8]; float ss = 0.f;
#pragma unroll
    for (int k = 0; k < 8; ++k) { d[k] = *(const LAS u32x4*)(F.lds + t_l * RS + (16 * k + cgp) * 16);
#pragma unroll
        for (int e = 0; e < 4; ++e) { const float a = bflo(d[k][e]), bq = bfhi(d[k][e]); ss += a * a + bq * bq; } }
    ss += __shfl_xor(ss, 1); ss += __shfl_xor(ss, 2); ss += __shfl_xor(ss, 4); ss += __shfl_xor(ss, 8);
    const float rstd = 1.0f / sqrtf(ss * (1.0f / 1024.0f) + LN_EPS);
    bf16* orow = F.mix + ((size_t)(b * SEQ + t0 + t_l)) * DM + 1024;
#pragma unroll
    for (int k = 0; k < 8; ++k) { const int c0 = (16 * k + cgp) * 8; const f32x4 g0 = *(const f32x4*)(F.hgain + c0), g1 = *(const f32x4*)(F.hgain + c0 + 4);
        u32x4 w; w.x = pk2(bflo(d[k].x) * rstd * g0.x, bfhi(d[k].x) * rstd * g0.y); w.y = pk2(bflo(d[k].y) * rstd * g0.z, bfhi(d[k].y) * rstd * g0.w);
        w.z = pk2(bflo(d[k].z) * rstd * g1.x, bfhi(d[k].z) * rstd * g1.y); w.w = pk2(bflo(d[k].w) * rstd * g1.z, bfhi(d[k].w) * rstd * g1.w);
        *(u32x4*)(orow + c0) = w; }
    __syncthreads();
}
__device__ __forceinline__ void ln_rows(Frame& F, float* buf, const float* g, const float* bt, bf16* ob) {
    const int gw = blockIdx.x * NWAVES + F.wave, NGW = F.G * NWAVES;
    for (int m = gw; m < M; m += NGW) {
        f32x4* row = (f32x4*)(buf + (size_t)m * DM) + F.lane;
        f32x4 v[8]; float s = 0.f;
#pragma unroll
        for (int j = 0; j < 8; ++j) { v[j] = row[64 * j]; s += (v[j].x + v[j].y) + (v[j].z + v[j].w); }
        const float mean = wave_sum(s) * (1.0f / DM); float s2 = 0.f;
#pragma unroll
        for (int j = 0; j < 8; ++j) { v[j] = v[j] - mean; s2 += (v[j].x * v[j].x + v[j].y * v[j].y) + (v[j].z * v[j].z + v[j].w * v[j].w); }
        const float rstd = 1.0f / sqrtf(wave_sum(s2) * (1.0f / DM) + LN_EPS);
#pragma unroll
        for (int j = 0; j < 8; ++j) { const f32x4 gg = ((const f32x4*)g)[F.lane + 64 * j], bb = ((const f32x4*)bt)[F.lane + 64 * j]; const f32x4 y = v[j] * rstd * gg + bb; row[64 * j] = y;
            if (ob) { u32x2 w; w.x = pk2(y.x, y.y); w.y = pk2(y.z, y.w); *((u32x2*)(ob + (size_t)m * DM) + F.lane + 64 * j) = w; } }
    }
}
#define XB_TMO      128
#define XB_XCNT(j)  (256  + 64 * (j))
#define XB_XSUB(j)  (1280 + 64 * (j))
#define XB_XGEN(j)  (2304 + 64 * (j))
#define XB_TOP      3328
#define XB_TOPGEN   3392
#define XCD_BAR_WORDS 3456
#define XB_SPIN_CAP (1u << 18)

__device__ __forceinline__ unsigned xb_ld(unsigned* p)              { return __hip_atomic_load(p, __ATOMIC_RELAXED, __HIP_MEMORY_SCOPE_AGENT); }
__device__ __forceinline__ unsigned xb_add(unsigned* p, unsigned v) { return __hip_atomic_fetch_add(p, v, __ATOMIC_RELAXED, __HIP_MEMORY_SCOPE_AGENT); }
__device__ __forceinline__ unsigned xb_xcc_id() { return (unsigned)__builtin_amdgcn_s_getreg((3 << 11) | 20) & 0xFu; }
#define XB_SPIN(cond, bar) do { unsigned _sp = 0; while (cond) { __builtin_amdgcn_s_sleep(1); \
    if ((++_sp & 255u) == 0u) { if (xb_ld(&(bar)[XB_TMO])) break; if (_sp > XB_SPIN_CAP) { atomicAdd(&(bar)[XB_TMO], 1u); break; } } } } while (0)

struct XcdBarrier {
    unsigned* bar; unsigned x;
    volatile LAS unsigned* st;
};

__device__ __forceinline__ XcdBarrier xcd_barrier_post(unsigned* bar, volatile LAS unsigned* st) {
    XcdBarrier b; b.bar = bar; b.x = xb_xcc_id(); b.st = st;
    if (threadIdx.x == 0) (void)xb_add(&bar[XB_XCNT(b.x)], 1u);
    return b;
}
__device__ __forceinline__ void xcd_barrier_complete(unsigned* bar, unsigned x, unsigned& nloc, unsigned& nx) {
    const unsigned G = gridDim.x * gridDim.y * gridDim.z;
    unsigned sum, cnt, mine, sp = 0u;
    for (;;) {
        sum = 0u; cnt = 0u; mine = 0u;
#pragma unroll
        for (unsigned j = 0; j < 16; ++j) { const unsigned c = xb_ld(&bar[XB_XCNT(j)]); sum += c; cnt += (c > 0u) ? 1u : 0u; mine = (j == x) ? c : mine; }
        if (sum == G) break;
        __builtin_amdgcn_s_sleep(1);
        if ((++sp & 255u) == 0u) { if (xb_ld(&bar[XB_TMO])) break; if (sp > XB_SPIN_CAP) { atomicAdd(&bar[XB_TMO], 1u); break; } }
    }
    nloc = mine > 0u ? mine : 1u; nx = cnt > 0u ? cnt : 1u;
}

__device__ __forceinline__ void xcd_barrier(const XcdBarrier& b) {
    asm volatile("s_waitcnt vmcnt(0)" ::: "memory");
    __syncthreads();
    if (threadIdx.x == 0) {
        unsigned* bar = b.bar;
        __builtin_amdgcn_s_waitcnt(0);
        unsigned nloc = b.st[0], nx = b.st[1];
        if (nloc == 0u) { xcd_barrier_complete(bar, b.x, nloc, nx); b.st[0] = nloc; b.st[1] = nx; }
        const unsigned old = xb_add(&bar[XB_XSUB(b.x)], 1u);
        const unsigned gen = old / nloc;
        if (old + 1u == (gen + 1u) * nloc) {
            __builtin_amdgcn_fence(__ATOMIC_RELEASE, "agent");
            asm volatile("s_waitcnt vmcnt(0)" ::: "memory");
            const unsigned og = xb_add(&bar[XB_TOP], 1u);
            const unsigned tg = og / nx;
            if (og + 1u == (tg + 1u) * nx) xb_add(&bar[XB_TOPGEN], 1u);
            else XB_SPIN(xb_ld(&bar[XB_TOPGEN]) == tg, bar);
            __builtin_amdgcn_fence(__ATOMIC_ACQUIRE, "agent");
            xb_add(&bar[XB_XGEN(b.x)], 1u);
            asm volatile("s_waitcnt vmcnt(0)" ::: "memory");
        } else {
            XB_SPIN(xb_ld(&bar[XB_XGEN(b.x)]) == gen, bar);
            __builtin_amdgcn_fence(__ATOMIC_ACQUIRE, "agent");
            asm volatile("s_waitcnt vmcnt(0)" ::: "memory");
        }
    }
    __syncthreads();
}

struct Args { const float* in[24]; float* out; unsigned char* ws; int ph_lo, ph_hi; };
constexpr int N_PHASES = 10;
__global__ void __launch_bounds__(NTHR, 2) hymba_fwd(Args args) {
    extern __shared__ __attribute__((aligned(16))) unsigned char lds_raw[];
    Frame F;
    F.lds = (LAS unsigned char*)lds_raw;
    F.tid = threadIdx.x; F.lane = F.tid & 63; F.wave = __builtin_amdgcn_readfirstlane(F.tid >> 6);
    F.G = gridDim.x; { const int bx = blockIdx.x; F.vcu = (F.G % 8 == 0) ? (bx % 8) * (F.G / 8) + bx / 8 : bx; }
    unsigned char* ws = args.ws;
    F.x = args.in[0]; F.w_in = args.in[1]; F.lq1 = args.in[2]; F.lk1 = args.in[3]; F.lq2 = args.in[4]; F.lk2 = args.in[5]; F.subg = args.in[6]; F.conv_w = args.in[7]; F.conv_b = args.in[8];
    F.fw1 = args.in[9]; F.fb1 = args.in[10]; F.ffreq = args.in[11]; F.fw2 = args.in[12]; F.fb2 = args.in[13]; F.fw3 = args.in[14]; F.hskip = args.in[15]; F.hgain = args.in[16];
    F.w_out = args.in[17]; F.ln1g = args.in[18]; F.ln1b = args.in[19]; F.w_ff1 = args.in[20]; F.w_ff2 = args.in[21]; F.ln2g = args.in[22]; F.ln2b = args.in[23]; F.out = args.out;
    F.WinT = (bf16*)(ws + WS_WIN); F.WoutT = (bf16*)(ws + WS_WOUT); F.Wff1T = (bf16*)(ws + WS_WFF1); F.Wff2T = (bf16*)(ws + WS_WFF2);
    F.xb = (bf16*)(ws + WS_XB); F.mix = (bf16*)(ws + WS_XB); F.proj = (bf16*)(ws + WS_PROJ); F.x1b = (bf16*)(ws + WS_X1B); F.yT = (bf16*)(ws + WS_YT);
    F.vgT = (bf16*)(ws + WS_VGT); F.x1T = (bf16*)(ws + WS_X1T); F.filt = (bf16*)(ws + WS_FILT); F.hbuf = (bf16*)(ws + WS_H);
    const int lo = args.ph_lo, hi = args.ph_hi;
    if (F.tid < 64) ((LAS unsigned*)(F.lds + LDS_STAGE_BYTES))[F.tid] = 0u;
    __syncthreads();
    XcdBarrier xbar = xcd_barrier_post((unsigned*)(ws + WS_CTL), (volatile LAS unsigned*)(F.lds + LDS_STAGE_BYTES) + 8);
#ifndef PHMASK
#define PHMASK 0x3ff
#endif
#define IN(k) ((((PHMASK) >> (k)) & 1) && lo <= (k) && (k) < hi)
#ifndef REPMASK
#define REPMASK 0
#endif
#define REP(k) for (int rep_ = 0; rep_ < ((((REPMASK) >> (k)) & 1) ? 2 : 1); ++rep_)
#define SEAM(k) do { if (IN(k) && IN((k) + 1)) { if ((k) == 0) cg::this_grid().sync(); else xcd_barrier(xbar); } } while (0)

    if (IN(0)) REP(0) {
        { LAS float* scr = (LAS float*)(F.lds + F.wave * 8704);
          const int gw = F.vcu * NWAVES + F.wave, NGW = F.G * NWAVES;
          constexpr int I_IN = (DM / 64) * (INC / 32), I_OUT = (DM / 64) * (DM / 32), I_F1 = (DM / 64) * (DFF / 32), I_F2 = (DFF / 64) * (DM / 32);
          for (int it = gw; it < I_IN + I_OUT + I_F1 + I_F2; it += NGW) { int r = it;
              if (r < I_IN) { p0_transpose_item(F.w_in, DM, INC, F.WinT, scr, r, F.lane); continue; } r -= I_IN;
              if (r < I_OUT) { p0_transpose_item(F.w_out, DM, DM, F.WoutT, scr, r, F.lane); continue; } r -= I_OUT;
              if (r < I_F1) { p0_transpose_item(F.w_ff1, DM, DFF, F.Wff1T, scr, r, F.lane); continue; } r -= I_F1;
              p0_transpose_item(F.w_ff2, DFF, DM, F.Wff2T, scr, r, F.lane); } }
        __syncthreads();
        for (int it = blockIdx.x; it < SEQ / 16; it += F.G) filter_item(F, it);
        { const size_t nchunk = (size_t)M * DM / 8; const f32x4* x4 = (const f32x4*)F.x; u32x4* xo = (u32x4*)F.xb;
          for (size_t ch = (size_t)blockIdx.x * NTHR + F.tid; ch < nchunk; ch += (size_t)F.G * NTHR) { const f32x4 a = x4[2 * ch], b = x4[2 * ch + 1]; u32x4 o; o.x = pk2(a.x, a.y); o.y = pk2(a.z, a.w); o.z = pk2(b.x, b.y); o.w = pk2(b.z, b.w); xo[ch] = o; } }
    }
    SEAM(0);
    if (IN(1)) REP(1) {
        pg8::Gemm g{F.xb, F.WinT, M, INC, DM}; pg8::StaticOrder S; S.init(M, INC, F.G, (int)blockIdx.x);
        pg8::EpiBf16<0> E{F.proj, INC, 1024, QSCALE};
        pg8::gemm_phase<pg8::EpiBf16<0>, pg8::StaticOrder, true, true>(F.lds, g, S, E);
    }
    SEAM(1);
    if (IN(2)) REP(2) { for (int it = blockIdx.x; it < 4096; it += F.G) h1_item(F, it); }
    SEAM(2);
    if (IN(3)) REP(3) {
        float sa = F.lq1[F.lane] * F.lk1[F.lane], sb = F.lq2[F.lane] * F.lk2[F.lane]; sa = wave_sum(sa); sb = wave_sum(sb);
        const float lam = __expf(sa) - __expf(sb) + 0.2f;
#ifndef REP_ATT
#define REP_ATT 1
#endif
#ifndef REP_HY
#define REP_HY 1
#endif
#ifndef NO_ATT
        for (int ra_ = 0; ra_ < REP_ATT; ++ra_) for (int u = F.vcu; u < 1024; u += F.G) att::attn_unit(F.lds, F.proj, F.mix, u >> 7, (u >> 4) & 7, u & 15, lam, F.subg);
#endif
#ifndef NO_HY
        for (int rh_ = 0; rh_ < REP_HY; ++rh_) for (int c = F.vcu; c < NCH; c += F.G) hy::conv_unit(F.lds, c, F.filt, F.vgT, F.x1T, F.yT, F.hskip);
#endif
    }
    SEAM(3);
    if (IN(4)) REP(4) { for (int it = blockIdx.x; it < 512; it += F.G) h3_item(F, it); }
    SEAM(4);
    if (IN(5)) REP(5) {
        pg8::Gemm g{F.mix, F.WoutT, M, DM, DM}; pg8::StaticOrder S; S.init(M, DM, F.G, (int)blockIdx.x);
        pg8::EpiResF32 E{F.x, F.out, DM, ALPHA};
        pg8::gemm_phase<pg8::EpiResF32, pg8::StaticOrder, true, true>(F.lds, g, S, E);
    }
    SEAM(5);
    if (IN(6)) ln_rows(F, F.out, F.ln1g, F.ln1b, F.x1b);
    SEAM(6);
    if (IN(7)) REP(7) {
        pg8::Gemm g{F.x1b, F.Wff1T, M, DFF, DM}; pg8::StaticOrder S; S.init(M, DFF, F.G, (int)blockIdx.x);
        pg8::EpiBf16<2> E{F.hbuf, DFF, 0, 1.f};
        pg8::gemm_phase<pg8::EpiBf16<2>, pg8::StaticOrder, true, true>(F.lds, g, S, E);
    }
    SEAM(7);
    if (IN(8)) {
        pg8::Gemm g{F.hbuf, F.Wff2T, M, DM, DFF}; pg8::StaticOrder S; S.init(M, DM, F.G, (int)blockIdx.x);
        pg8::EpiResF32 E{F.out, F.out, DM, ALPHA};
        pg8::gemm_phase<pg8::EpiResF32, pg8::StaticOrder, true, true>(F.lds, g, S, E);
    }
    SEAM(8);
#ifdef EXTRA_SYNCS
    for (int es_ = 0; es_ < EXTRA_SYNCS; ++es_) cg::this_grid().sync();
#endif
    if (IN(9)) ln_rows(F, F.out, F.ln2g, F.ln2b, nullptr);
#undef IN
#undef SEAM
}

#ifndef MK_N_LAUNCHES
#define MK_N_LAUNCHES 1
#endif
extern "C" void kernel_launch(void* const* d_in, const int* in_sizes, int n_in, void* d_out, int out_size, void* d_ws, size_t ws_size, hipStream_t stream) {
    static int grid = 0;
    if (grid == 0) {
        if (n_in != 24 || in_sizes[0] != M * DM || out_size != M * DM || ws_size < WS_END) { fprintf(stderr, "kernel_launch: unexpected problem shape (n_in %d, in0 %d, out %d, ws %zu); nothing launched\n", n_in, n_in > 0 ? in_sizes[0] : -1, out_size, ws_size); grid = -1; return; }
        int dev = 0, cus = 0, per_cu = 0;
        if (hipGetDevice(&dev) != hipSuccess || hipDeviceGetAttribute(&cus, hipDeviceAttributeMultiprocessorCount, dev) != hipSuccess) { grid = -1; return; }
        if (hipFuncSetAttribute((const void*)hymba_fwd, hipFuncAttributeMaxDynamicSharedMemorySize, LDS_BYTES) != hipSuccess) { fprintf(stderr, "kernel_launch: hipFuncSetAttribute failed\n"); grid = -1; return; }
        if (hipOccupancyMaxActiveBlocksPerMultiprocessor(&per_cu, (const void*)hymba_fwd, NTHR, LDS_BYTES) != hipSuccess || per_cu < 1) { fprintf(stderr, "kernel_launch: occupancy query says %d blocks per CU\n", per_cu); per_cu = 1; }
        (void)hipGetLastError();
        grid = cus * per_cu;
    }
    if (grid < 0) return;
    if (hipMemsetAsync((char*)d_ws + WS_CTL, 0, CTL_ZERO_BYTES, stream) != hipSuccess) { fprintf(stderr, "kernel_launch: hipMemsetAsync failed\n"); return; }
    Args a{};
    for (int i = 0; i < 24; ++i) a.in[i] = (const float*)d_in[i];
    a.out = (float*)d_out; a.ws = (unsigned char*)d_ws;
#if MK_N_LAUNCHES == 1
    a.ph_lo = 0; a.ph_hi = N_PHASES;
    void* kargs[] = {&a};
    const hipError_t e = hipLaunchCooperativeKernel((const void*)hymba_fwd, dim3(grid), dim3(NTHR), kargs, LDS_BYTES, stream);
    if (e != hipSuccess) fprintf(stderr, "kernel_launch: cooperative launch failed: %s (grid %d)\n", hipGetErrorString(e), grid);
#else
    for (int p = 0; p < N_PHASES; ++p) { a.ph_lo = p; a.ph_hi = p + 1; hipLaunchKernelGGL(hymba_fwd, dim3(grid), dim3(NTHR), LDS_BYTES, stream, a); }
#endif
}
```

```cpp
#include <hip/hip_runtime.h>
#include <hip/hip_cooperative_groups.h>
#include <cstdio>
#include <cstdint>
namespace cg = cooperative_groups;
namespace pg8 {
#define PG8_LAS __attribute__((address_space(3)))
typedef unsigned short bf16_t;
typedef short bf16x8 __attribute__((ext_vector_type(8)));
typedef float f32x4 __attribute__((ext_vector_type(4)));
typedef unsigned u32x4 __attribute__((ext_vector_type(4)));
constexpr int BM = 256, BK = 64, HALF = 128, HTB = HALF * BK * 2  , STAGE_BYTES = 8 * HTB, NXCD = 8, WGM = 8;

__host__ __device__ __forceinline__ int lds_byte(int r, int c) { const int st = (r >> 4) * 2 + (c >> 5), rr = r & 15, cc = c & 31, ob = rr * 64 + cc * 2; return st * 1024 + (ob ^ (((ob >> 9) & 1) << 5)); }
__host__ __device__ __forceinline__ void stage_rc(int b, int& R, int& C) { const int st = b / 1024, sb = b % 1024, swz = sb ^ (((sb >> 9) & 1) << 5); R = (st >> 1) * 16 + swz / 64; C = (st & 1) * 32 + (swz % 64) / 2; }
__host__ __device__ __forceinline__ int perm32(int rho) { const int n = rho >> 4, i = rho & 15; return 8 * (i >> 2) + 4 * n + (i & 3); }

struct Unit { int pm, pn; };
struct Gemm { const bf16_t* A; const bf16_t* Bt; int M, N, K; };

struct StaticOrder {
    int nM, nN, nwg, G, c;
    __host__ __device__ void init(int M, int N, int G_, int c_) { nM = M / BM; nN = N / BM; nwg = nM * nN; G = G_; c = c_; }
    __host__ __device__ bool next(int i, Unit& u) const {
        const long L = (long)i * G + c; if (L >= nwg) return false;
        int wgid = (int)L; { const int q = nwg / NXCD, r = nwg % NXCD, xcd = wgid % NXCD, off = wgid / NXCD; wgid = (xcd < r ? xcd * (q + 1) : r * (q + 1) + (xcd - r) * q) + off; }
        const int nig = WGM * nN, gid = wgid / nig, fm = gid * WGM, gsz = (nM - fm) < WGM ? (nM - fm) : WGM;
        u.pm = fm + ((wgid % nig) % gsz); u.pn = (wgid % nig) / gsz; return true;
    }
    __device__ __forceinline__ void a_ready(const Unit&) const {}
    __device__ __forceinline__ void done(const Unit&) const {}
};

__device__ __forceinline__ unsigned cvt_pk_bf16(float lo, float hi) { unsigned r; asm volatile("v_cvt_pk_bf16_f32 %0, %1, %2" : "=v"(r) : "v"(lo), "v"(hi)); return r; }
typedef float f32x2 __attribute__((ext_vector_type(2)));
template <int ACT> struct EpiBf16 {
    static constexpr bool PERM = true, AFTER_DRAIN = false;
    bf16_t* O; int ldc; int scale_cols; float scale0;
    __device__ __forceinline__ void operator()(const f32x4 (&acc)[2][2][4][2], const Unit& u, int wr, int wc, int fr, int fq) const {
        const int row0 = u.pm * BM + wr * 64 + fr; const int colt = u.pn * BM;
        const float sc = (colt < scale_cols) ? scale0 : 1.f;
        const int col0 = colt + wc * 32 + 8 * fq;
#pragma unroll
        for (int ai = 0; ai < 2; ++ai)
#pragma unroll
            for (int m = 0; m < 4; ++m) { bf16_t* rowp = O + (size_t)(row0 + ai * HALF + m * 16) * ldc + col0;
#pragma unroll
                for (int bj = 0; bj < 2; ++bj) { f32x4 v0 = acc[ai][bj][m][0], v1 = acc[ai][bj][m][1];
                    if (ACT == 2) {
#pragma unroll
                        for (int e = 0; e < 4; ++e) { const float a = v0[e] > 0.f ? v0[e] : 0.f, b = v1[e] > 0.f ? v1[e] : 0.f; v0[e] = a * a; v1[e] = b * b; } }
                    v0 = v0 * sc; v1 = v1 * sc; u32x4 w; w.x = cvt_pk_bf16(v0[0], v0[1]); w.y = cvt_pk_bf16(v0[2], v0[3]); w.z = cvt_pk_bf16(v1[0], v1[1]); w.w = cvt_pk_bf16(v1[2], v1[3]);
                    *(u32x4*)(rowp + bj * HALF) = w; } }
    }
};
struct EpiResF32 {
    static constexpr bool PERM = false, AFTER_DRAIN = false;
    const float* base; float* out; int ldc; float alpha;
    __device__ __forceinline__ void operator()(const f32x4 (&acc)[2][2][4][2], const Unit& u, int wr, int wc, int fr, int fq) const {
        const int col0 = u.pn * BM + wc * 32 + 4 * fq;
#pragma unroll
        for (int ai = 0; ai < 2; ++ai)
#pragma unroll
            for (int m = 0; m < 4; ++m) { const size_t off = (size_t)(u.pm * BM + ai * HALF + wr * 64 + m * 16 + fr) * ldc + col0;
#pragma unroll
                for (int bj = 0; bj < 2; ++bj)
#pragma unroll
                    for (int n = 0; n < 2; ++n) { const f32x4 bs = *(const f32x4*)(base + off + bj * HALF + n * 16); const f32x4 o = bs * alpha + acc[ai][bj][m][n]; *(f32x4*)(out + off + bj * HALF + n * 16) = o; }
                asm volatile("" ::: "memory"); }
    }
};
template <class Epi, class Sched, bool ALIGN_EPI = false, bool SP2 = false>
__device__ __forceinline__ void gemm_phase(PG8_LAS unsigned char* lds, const Gemm g, const Sched& S, const Epi& E) {
    const int tid = threadIdx.x, wid = __builtin_amdgcn_readfirstlane(tid >> 6), lane = tid & 63, wr = wid >> 2, wc = wid & 3, fr = lane & 15, fq = lane >> 4;
    const int K = g.K, nt = K / BK;
    unsigned voffA[2], voffB[2];
#pragma unroll
    for (int i = 0; i < 2; ++i) { int R, C; stage_rc(tid * 16 + i * 8192, R, C); const int Rb = Epi::PERM ? ((R & ~31) + perm32(R & 31)) : R;
        voffA[i] = (unsigned)(R * K + C) * 2u; voffB[i] = (unsigned)(Rb * K + C) * 2u; }
    const size_t kstep = (size_t)(BK * 2);
    const size_t hstep = (size_t)HALF * K * 2;
    const size_t tstep = 2 * hstep;
    const unsigned ldsw = (unsigned)wid * 1024u;
    const int aoff = lds_byte(wr * 64 + fr, fq * 8), boff = lds_byte(wc * 32 + fr, fq * 8);
#define PG8_SA(b, h) (((b) * 2 + (h)) * HTB)
#define PG8_SB(b, h) ((4 + (b) * 2 + (h)) * HTB)
#define PG8_STAGE(bufoff, gbase, voff) do { _Pragma("unroll") for (int _i = 0; _i < 2; ++_i) \
        __builtin_amdgcn_global_load_lds((const unsigned*)((const char*)(gbase) + (voff)[_i]), (PG8_LAS unsigned*)(lds + (bufoff) + ldsw + _i * 8192), 16, 0, 0); } while (0)
#define PG8_LDA(dst, b, h) do { _Pragma("unroll") for (int m = 0; m < 4; ++m) _Pragma("unroll") for (int k = 0; k < 2; ++k) dst[m][k] = *(const PG8_LAS bf16x8*)(lds + PG8_SA(b, h) + aoff + m * 2048 + k * 1024); } while (0)
#define PG8_LDB(dst, b, h) do { _Pragma("unroll") for (int n = 0; n < 2; ++n) _Pragma("unroll") for (int k = 0; k < 2; ++k) dst[n][k] = *(const PG8_LAS bf16x8*)(lds + PG8_SB(b, h) + boff + n * 2048 + k * 1024); } while (0)
#define PG8_MMA(ai, bj, At, Bt) do { __builtin_amdgcn_s_setprio(1); _Pragma("unroll") for (int m = 0; m < 4; ++m) _Pragma("unroll") for (int n = 0; n < 2; ++n) _Pragma("unroll") for (int k = 0; k < 2; ++k) \
        acc[ai][bj][m][n] = __builtin_amdgcn_mfma_f32_16x16x32_bf16(Bt[n][k], At[m][k], acc[ai][bj][m][n], 0, 0, 0); __builtin_amdgcn_s_setprio(0); } while (0)
#define PG8_WAIT_V(n) asm volatile("s_waitcnt vmcnt(" #n ")" ::: "memory")
#define PG8_WAIT_L(n) asm volatile("s_waitcnt lgkmcnt(" #n ")" ::: "memory")
#define PG8_BAR __builtin_amdgcn_s_barrier()
#define PG8_SCHED __builtin_amdgcn_sched_barrier(0)
    Unit cur, nxt; int ui = 0;
    if (!S.next(0, cur)) return;
    f32x4 acc[2][2][4][2];
#pragma unroll
    for (int a = 0; a < 2; ++a)
#pragma unroll
        for (int b = 0; b < 2; ++b)
#pragma unroll
            for (int m = 0; m < 4; ++m)
#pragma unroll
                for (int n = 0; n < 2; ++n) acc[a][b][m][n] = (f32x4){0.f, 0.f, 0.f, 0.f};
    bf16x8 At[4][2], B0[2][2], B1[2][2];
    const char* cA = (const char*)g.A + (size_t)cur.pm * tstep; const char* cB = (const char*)g.Bt + (size_t)cur.pn * tstep;
    S.a_ready(cur);
    if constexpr (SP2) {
        PG8_STAGE(PG8_SB(0, 0), cB, voffB); PG8_STAGE(PG8_SB(0, 1), cB + hstep, voffB); PG8_STAGE(PG8_SA(0, 0), cA, voffA); PG8_STAGE(PG8_SA(0, 1), cA + hstep, voffA);
        if (wr == 1) PG8_BAR;
        PG8_WAIT_V(2); PG8_BAR;
        PG8_STAGE(PG8_SB(1, 0), cB + kstep, voffB); PG8_STAGE(PG8_SA(1, 0), cA + kstep, voffA); PG8_STAGE(PG8_SB(1, 1), cB + hstep + kstep, voffB);
        PG8_WAIT_V(6); PG8_BAR;
    } else {
        PG8_STAGE(PG8_SB(0, 0), cB, voffB); PG8_STAGE(PG8_SA(0, 0), cA, voffA); PG8_STAGE(PG8_SB(0, 1), cB + hstep, voffB); PG8_STAGE(PG8_SA(0, 1), cA + hstep, voffA);
        if (wr == 1) PG8_BAR;
        PG8_WAIT_V(4); PG8_BAR;
        PG8_STAGE(PG8_SB(1, 0), cB + kstep, voffB); PG8_STAGE(PG8_SA(1, 0), cA + kstep, voffA); PG8_STAGE(PG8_SB(1, 1), cB + hstep + kstep, voffB);
        PG8_WAIT_V(6); PG8_BAR;
    }
    for (;;) {
        const bool has_next = S.next(ui + 1, nxt);
        const char* nA = has_next ? (const char*)g.A + (size_t)nxt.pm * tstep : cA; const char* nB = has_next ? (const char*)g.Bt + (size_t)nxt.pn * tstep : cB;
        for (int t = 0; t < nt; t += 2) {
            const bool last = (t == nt - 2);
            const char* a1 = cA + (size_t)(t + 1) * kstep;
            const char* a2 = last ? nA : cA + (size_t)(t + 2) * kstep; const char* b2 = last ? nB : cB + (size_t)(t + 2) * kstep;
            const char* a3 = a2 + kstep; const char* b3 = b2 + kstep;
            if (last && has_next) S.a_ready(nxt);
            if constexpr (SP2) {
            PG8_LDB(B0, 0, 0); PG8_LDB(B1, 0, 1); PG8_SCHED; PG8_LDA(At, 0, 0); PG8_STAGE(PG8_SA(1, 1), a1 + hstep, voffA);
            PG8_WAIT_V(8); PG8_WAIT_L(0); PG8_BAR; PG8_MMA(0, 0, At, B0); PG8_MMA(0, 1, At, B1); PG8_BAR; PG8_SCHED;
            PG8_LDA(At, 0, 1); PG8_STAGE(PG8_SB(0, 0), b2, voffB); PG8_STAGE(PG8_SB(0, 1), b2 + hstep, voffB); PG8_STAGE(PG8_SA(0, 0), a2, voffA);
            PG8_WAIT_V(8); PG8_WAIT_L(0); PG8_BAR; PG8_MMA(1, 0, At, B0); PG8_MMA(1, 1, At, B1); PG8_BAR; PG8_SCHED;
            PG8_LDB(B0, 1, 0); PG8_LDB(B1, 1, 1); PG8_SCHED; PG8_LDA(At, 1, 0); PG8_STAGE(PG8_SA(0, 1), a2 + hstep, voffA);
            PG8_WAIT_V(8); PG8_WAIT_L(0); PG8_BAR; PG8_MMA(0, 0, At, B0); PG8_MMA(0, 1, At, B1); PG8_BAR; PG8_SCHED;
            PG8_LDA(At, 1, 1); PG8_STAGE(PG8_SB(1, 0), b3, voffB); PG8_STAGE(PG8_SB(1, 1), b3 + hstep, voffB); PG8_STAGE(PG8_SA(1, 0), a3, voffA);
            PG8_WAIT_V(8); PG8_WAIT_L(0); PG8_BAR; PG8_MMA(1, 0, At, B0); PG8_MMA(1, 1, At, B1); PG8_BAR; PG8_SCHED;
            } else {
            PG8_LDB(B0, 0, 0); PG8_SCHED; PG8_LDA(At, 0, 0); PG8_STAGE(PG8_SA(1, 1), a1 + hstep, voffA);
            PG8_WAIT_L(8); PG8_BAR; PG8_WAIT_L(0); PG8_MMA(0, 0, At, B0); PG8_BAR; PG8_SCHED;
            PG8_LDB(B1, 0, 1); PG8_STAGE(PG8_SB(0, 0), b2, voffB);
            PG8_BAR; PG8_WAIT_L(0); PG8_MMA(0, 1, At, B1); PG8_BAR;
            PG8_LDA(At, 0, 1); PG8_STAGE(PG8_SA(0, 0), a2, voffA);
            PG8_BAR; PG8_WAIT_L(0); PG8_MMA(1, 0, At, B0); PG8_BAR; PG8_SCHED;
            PG8_STAGE(PG8_SB(0, 1), b2 + hstep, voffB);
            PG8_WAIT_V(6); PG8_BAR; PG8_MMA(1, 1, At, B1); PG8_BAR;
            PG8_LDB(B0, 1, 0); PG8_SCHED; PG8_LDA(At, 1, 0); PG8_STAGE(PG8_SA(0, 1), a2 + hstep, voffA);
            PG8_WAIT_L(8); PG8_BAR; PG8_WAIT_L(0); PG8_MMA(0, 0, At, B0); PG8_BAR; PG8_SCHED;
            PG8_LDB(B1, 1, 1); PG8_STAGE(PG8_SB(1, 0), b3, voffB);
            PG8_BAR; PG8_WAIT_L(0); PG8_MMA(0, 1, At, B1); PG8_BAR;
            PG8_LDA(At, 1, 1); PG8_STAGE(PG8_SA(1, 0), a3, voffA);
            PG8_BAR; PG8_WAIT_L(0); PG8_MMA(1, 0, At, B0); PG8_BAR; PG8_SCHED;
            PG8_STAGE(PG8_SB(1, 1), b3 + hstep, voffB);
            PG8_WAIT_V(6); PG8_BAR; PG8_MMA(1, 1, At, B1); PG8_BAR;
            }
        }
        if constexpr (ALIGN_EPI) { if (wr == 0) PG8_BAR; }
        if constexpr (!Epi::AFTER_DRAIN) { E(acc, cur, wr, wc, fr, fq); S.done(cur); }
        if (!has_next) break;
#pragma unroll
        for (int a = 0; a < 2; ++a)
#pragma unroll
            for (int b = 0; b < 2; ++b)
#pragma unroll
                for (int m = 0; m < 4; ++m)
#pragma unroll
                    for (int n = 0; n < 2; ++n) acc[a][b][m][n] = (f32x4){0.f, 0.f, 0.f, 0.f};
        cur = nxt; cA = nA; cB = nB; ++ui;
        if constexpr (ALIGN_EPI) { if (wr == 1) PG8_BAR; }
    }
    PG8_WAIT_V(0);
    if constexpr (!ALIGN_EPI) { if (wr == 0) PG8_BAR; }
    PG8_BAR;
    if constexpr (Epi::AFTER_DRAIN) { E.fused(acc, cur, wr, wc, fr, fq, lds, wid, lane); S.done(cur); }
#undef PG8_SA
#undef PG8_SB
#undef PG8_STAGE
#undef PG8_LDA
#undef PG8_LDB
#undef PG8_MMA
#undef PG8_WAIT_V
#undef PG8_WAIT_L
#undef PG8_BAR
#undef PG8_SCHED
}
}
#define LAS __attribute__((address_space(3)))
typedef pg8::bf16_t bf16;
typedef unsigned u32x4 __attribute__((ext_vector_type(4)));
typedef unsigned u32x2 __attribute__((ext_vector_type(2)));
typedef float f32x4 __attribute__((ext_vector_type(4)));
typedef float f32x16 __attribute__((ext_vector_type(16)));
typedef short bf16x8 __attribute__((ext_vector_type(8)));
typedef short s16x4 __attribute__((ext_vector_type(4)));
constexpr int NWAVES = 8, NTHR = 512;
constexpr int DM = 2048, BATCH = 8, SEQ = 2048, M = BATCH * SEQ, INC = 6144, DFF = 8192, NCH = 1024;
constexpr float ALPHA = 1.189207115002721f;
constexpr float LN_EPS = 1e-5f, LOG2E = 1.4426950408889634f, QSCALE = 0.125f * LOG2E;
constexpr size_t MiB = 1u << 20;
constexpr size_t WS_WIN = 1 * MiB, WS_WOUT = 25 * MiB, WS_WFF1 = 33 * MiB, WS_WFF2 = 65 * MiB;
constexpr size_t WS_XB = 97 * MiB;
constexpr size_t WS_PROJ = 161 * MiB;
constexpr size_t WS_X1B = 353 * MiB;
constexpr size_t WS_YT = 353 * MiB, WS_VGT = 417 * MiB, WS_X1T = 449 * MiB, WS_FILT = 481 * MiB;
constexpr size_t WS_H = 97 * MiB;
constexpr size_t WS_END = 489 * MiB;
constexpr size_t WS_CTL = 0, CTL_ZERO_BYTES = 65536;
constexpr int LDS_STAGE_BYTES = 131072, LDS_BYTES = LDS_STAGE_BYTES + 256;

__device__ __forceinline__ unsigned pk2(float lo, float hi) { return pg8::cvt_pk_bf16(lo, hi); }
__device__ __forceinline__ unsigned short f2bf(float f) { unsigned u = __builtin_bit_cast(unsigned, f); return (unsigned short)((u + 0x7fffu + ((u >> 16) & 1u)) >> 16); }
__device__ __forceinline__ float bflo(unsigned w) { return __uint_as_float(w << 16); }
__device__ __forceinline__ float bfhi(unsigned w) { return __uint_as_float(w & 0xffff0000u); }
__device__ __forceinline__ float wave_sum(float v) {
#pragma unroll
    for (int o = 1; o < 64; o <<= 1) v += __shfl_xor(v, o);
    return v;
}
__device__ __forceinline__ float half_swap_max(float v) { auto rr = __builtin_amdgcn_permlane32_swap(__float_as_uint(v), __float_as_uint(v), false, false); return fmaxf(__uint_as_float(rr[0]), __uint_as_float(rr[1])); }
__device__ __forceinline__ float half_swap_sum(float v) { auto rr = __builtin_amdgcn_permlane32_swap(__float_as_uint(v), __float_as_uint(v), false, false); return __uint_as_float(rr[0]) + __uint_as_float(rr[1]); }

struct Frame {
    LAS unsigned char* lds;
    int tid, lane, wave, vcu, G;
    const float *x, *w_in, *lq1, *lk1, *lq2, *lk2, *subg, *conv_w, *conv_b, *fw1, *fb1, *ffreq, *fw2, *fb2, *fw3, *hskip, *hgain, *w_out, *ln1g, *ln1b, *w_ff1, *w_ff2, *ln2g, *ln2b;
    float* out;
    bf16 *WinT, *WoutT, *Wff1T, *Wff2T, *xb, *mix, *proj, *x1b, *yT, *vgT, *x1T, *filt, *hbuf;
};

__device__ __forceinline__ void p0_transpose_item(const float* W, int K, int N, bf16* WT, LAS float* scr, int item, int lane) {
    const int nblk = N / 32, kb = item / nblk, nb = item % nblk, k0 = 64 * kb, n0 = 32 * nb;
#pragma unroll 8
    for (int i = 0; i < 32; ++i) { const int kk = 2 * i + (lane >> 5); scr[kk * 33 + (lane & 31)] = W[(size_t)(k0 + kk) * N + n0 + (lane & 31)]; }
    asm volatile("s_waitcnt lgkmcnt(0)" ::: "memory");
    const int c = lane & 7;
#pragma unroll
    for (int j = 0; j < 4; ++j) { const int n = (lane >> 3) + 8 * j; const LAS float* s = scr + (8 * c) * 33 + n;
        u32x4 o; o.x = pk2(s[0 * 33], s[1 * 33]); o.y = pk2(s[2 * 33], s[3 * 33]); o.z = pk2(s[4 * 33], s[5 * 33]); o.w = pk2(s[6 * 33], s[7 * 33]);
        *(u32x4*)(WT + (size_t)(n0 + n) * K + k0 + 8 * c) = o; }
    asm volatile("s_waitcnt lgkmcnt(0)" ::: "memory");
}
__device__ __forceinline__ void filter_item(Frame& F, int it) {
    LAS float* zs = (LAS float*)F.lds; LAS float* h1s = zs + 16 * 33; LAS float* h2s = h1s + 16 * 64;
    const int tid = F.tid, l0 = it * 16;
    for (int idx = tid; idx < 16 * 33; idx += NTHR) { const int r = idx / 33, e = idx - r * 33, l = l0 + r; float val;
        if (e == 0) val = (float)l / 2047.0f;
        else { const int j = (e - 1) & 15; const float f = 1e-4f + (float)j * ((15.0f - 1e-4f) / 15.0f); const float w = (6.283185307179586f * (float)l) / 2048.0f; const float a = f * w; val = (e <= 16) ? __cosf(a) : -__sinf(a); }
        zs[idx] = val; }
    __syncthreads();
    for (int idx = tid; idx < 1024; idx += NTHR) { const int r = idx >> 6, o = idx & 63; float a = F.fb1[o];
        for (int e = 0; e < 33; ++e) a += zs[r * 33 + e] * F.fw1[e * 64 + o];
        h1s[idx] = __sinf(F.ffreq[o] * a); }
    __syncthreads();
    for (int idx = tid; idx < 1024; idx += NTHR) { const int r = idx >> 6, o = idx & 63; float a = F.fb2[o];
        for (int e = 0; e < 64; ++e) a += h1s[r * 64 + e] * F.fw2[e * 64 + o];
        h2s[idx] = __sinf(F.ffreq[o] * a); }
    __syncthreads();
    const int n0 = tid * 4;
    f32x4 acc[16];
#pragma unroll
    for (int r = 0; r < 16; ++r) acc[r] = (f32x4){0.f, 0.f, 0.f, 0.f};
    for (int k = 0; k < 64; k += 4) {
        const f32x4 w0 = *(const f32x4*)(F.fw3 + (size_t)(k + 0) * 2048 + n0), w1 = *(const f32x4*)(F.fw3 + (size_t)(k + 1) * 2048 + n0),
                    w2 = *(const f32x4*)(F.fw3 + (size_t)(k + 2) * 2048 + n0), w3 = *(const f32x4*)(F.fw3 + (size_t)(k + 3) * 2048 + n0);
#pragma unroll
        for (int r = 0; r < 16; ++r) { const f32x4 hv = *(const LAS f32x4*)(h2s + r * 64 + k); acc[r] += w0 * hv.x + w1 * hv.y + w2 * hv.z + w3 * hv.w; }
    }
    const int ch0 = n0 & 1023; const bool fwd = n0 < 1024;
    const float DMIN = -3.0701134573253945f, DMAX = -15.350567286626972f;
#pragma unroll
    for (int e = 0; e < 4; ++e) { const int ch = ch0 + e; const float ad = fabsf(DMIN + (float)ch * ((DMAX - DMIN) / 1023.0f)); bf16* dst = F.filt + (size_t)ch * 4096;
#pragma unroll
        for (int r = 0; r < 16; ++r) { const int l = l0 + r; const float tl = (float)l / 2047.0f; const float val = acc[r][e] * __expf(-tl * ad);
            if (fwd) dst[2048 - l] = f2bf(val); else if (l >= 1) dst[2048 + l] = f2bf(val); }
        if (it == 0 && fwd) dst[0] = 0; }
    __syncthreads();
}
__device__ __forceinline__ void h1_item(Frame& F, int item) {
    const int cblk = item & 15, sblk = (item >> 4) & 31, b = item >> 9;
    const int tid = F.tid, s_l = tid >> 3, cg8 = tid & 7;
    const int s = sblk * 64 + s_l, c = cblk * 64 + cg8 * 8;
    const bf16* row = F.proj + ((size_t)(b * SEQ + s)) * INC + 3072 + c;
    float z[3][8];
#pragma unroll
    for (int a = 0; a < 3; ++a) { const bf16* p = row + a * 1024;
        u32x4 um = (u32x4){0u, 0u, 0u, 0u}, up = (u32x4){0u, 0u, 0u, 0u}; const u32x4 u0 = *(const u32x4*)p;
        if (s > 0) um = *(const u32x4*)(p - INC);
        if (s < SEQ - 1) up = *(const u32x4*)(p + INC);
        const float* cw = F.conv_w + a * 1024 + c; const float* cb = F.conv_b + a * 1024 + c;
#pragma unroll
        for (int e2 = 0; e2 < 4; ++e2) {
            const float m0 = bflo(um[e2]), m1 = bfhi(um[e2]), c0 = bflo(u0[e2]), c1 = bfhi(u0[e2]), p0 = bflo(up[e2]), p1 = bfhi(up[e2]);
            z[a][2 * e2]     = cb[2 * e2]     + m0 * cw[2 * e2]     + c0 * cw[3072 + 2 * e2]     + p0 * cw[6144 + 2 * e2];
            z[a][2 * e2 + 1] = cb[2 * e2 + 1] + m1 * cw[2 * e2 + 1] + c1 * cw[3072 + 2 * e2 + 1] + p1 * cw[6144 + 2 * e2 + 1]; } }
    LAS unsigned short* tv = (LAS unsigned short*)F.lds; LAS unsigned short* tx = tv + 64 * 66;
#pragma unroll
    for (int e = 0; e < 8; ++e) { tv[(cg8 * 8 + e) * 66 + s_l] = f2bf(z[2][e] * z[1][e]); tx[(cg8 * 8 + e) * 66 + s_l] = f2bf(z[0][e]); }
    __syncthreads();
    { const int c_l = tid >> 3, chunk = tid & 7;
      const LAS unsigned* pv = (const LAS unsigned*)(F.lds + c_l * 132 + chunk * 16); const LAS unsigned* px = (const LAS unsigned*)(F.lds + 64 * 132 + c_l * 132 + chunk * 16);
      u32x4 ov, ox; ov.x = pv[0]; ov.y = pv[1]; ov.z = pv[2]; ov.w = pv[3]; ox.x = px[0]; ox.y = px[1]; ox.z = px[2]; ox.w = px[3];
      const size_t go = ((size_t)((cblk * 64 + c_l) * 8 + b)) * 2048 + sblk * 64 + chunk * 8;
      *(u32x4*)(F.vgT + go) = ov; *(u32x4*)(F.x1T + go) = ox; }
    __syncthreads();
}
namespace att {
constexpr int KOFF = 0, VOFF = 32768, QOFF = 65536;
__device__ __forceinline__ int toff(int row, int ch) { return 256 * row + 16 * (ch ^ (((row & 3) << 2) | ((row >> 2) & 3))); }
#define MFMA32(a, b, c) __builtin_amdgcn_mfma_f32_32x32x16_bf16((a), (b), (c), 0, 0, 0)
__device__ __forceinline__ void glds16(const void* gsrc, unsigned lds_dst) { unsigned keep;
    asm volatile("s_mov_b32 %0, m0\n\ts_mov_b32 m0, %2\n\ts_nop 0\n\tglobal_load_lds_dwordx4 %1, off\n\ts_mov_b32 m0, %0" : "=&s"(keep) : "v"(gsrc), "s"(lds_dst) : "memory"); }
__device__ __forceinline__ float a_add(float a, float b) { float r; asm("v_add_f32_e32 %0, %1, %2" : "=v"(r) : "v"(a), "v"(b)); return r; }
__device__ __forceinline__ float a_sub(float a, float b) { float r; asm("v_sub_f32_e32 %0, %1, %2" : "=v"(r) : "v"(a), "v"(b)); return r; }
__device__ __forceinline__ float a_max3(float a, float b, float c) { float r; asm("v_max3_f32 %0, %1, %2, %3" : "=v"(r) : "v"(a), "v"(b), "v"(c)); return r; }
__device__ __forceinline__ float a_bias(float nsl2, float t, float negm) { float r; asm("v_fma_f32 %0, %1, |%2|, %3" : "=v"(r) : "v"(nsl2), "v"(t), "v"(negm)); return r; }
typedef float f32x2_t __attribute__((ext_vector_type(2))); typedef __bf16 bf16x2_t __attribute__((ext_vector_type(2)));
__device__ __forceinline__ unsigned cvtpk_m(float lo, float hi) { f32x2_t v = {lo, hi}; bf16x2_t b = __builtin_convertvector(v, bf16x2_t); return __builtin_bit_cast(unsigned, b); }
template <int K> __device__ __forceinline__ float a_subk(float b) { float r; asm("v_subrev_f32_e32 %0, %1, %2" : "=v"(r) : "n"(__builtin_bit_cast(int, (float)K)), "v"(b)); return r; }
#define ATT_WAIT_BAR(N) asm volatile("s_waitcnt vmcnt(" #N ") lgkmcnt(0)\n\ts_barrier" ::: "memory")
__device__ __forceinline__ s16x4 vtr(const LAS unsigned char* p) { return __builtin_bit_cast(s16x4, __builtin_amdgcn_ds_read_tr16_b64_v4i16((LAS s16x4*)p)); }

__device__ __forceinline__ void attn_unit(LAS unsigned char* lds, const bf16* proj, bf16* mix, int b, int h, int qb, float lam, const float* subg) {
    const int tid = threadIdx.x, lane = tid & 63, r32 = lane & 31, hi = lane >> 5;
    const int wid = __builtin_amdgcn_readfirstlane(tid >> 6);
    const int c = wid >> 2, qi = wid & 3; const bool grpB = (wid >= 4);
    const size_t rowbase = (size_t)b * SEQ;
    const int qpos = qb * 128 + qi * 32 + r32;
    constexpr int NT = SEQ / 64, SLOT = 32768, VO = 16384;
    bf16x8 qf[4];
    { const bf16* qg = proj + (rowbase + qpos) * INC + h * 128 + c * 64 + hi * 8;
#pragma unroll
      for (int d0 = 0; d0 < 4; ++d0) qf[d0] = *(const bf16x8*)(qg + d0 * 16); }
    const bf16* kvg = proj + rowbase * INC + 1024 + h * 128;
    size_t goff[2];
#pragma unroll
    for (int j = 0; j < 2; ++j) { const int row = 8 * wid + 4 * j + (lane >> 4); const int sw = ((lane >> 4) << 2) | ((2 * wid + j) & 3); goff[j] = (size_t)row * INC + 8 * ((lane & 15) ^ sw); }
    const unsigned lds0 = (unsigned)(uintptr_t)lds;
#define ATT_STAGE(t_, slot_) do { const int tt_ = (t_) < NT ? (t_) : NT - 1; const bf16* kt_ = kvg + (size_t)tt_ * 64 * INC; _Pragma("unroll") for (int j_ = 0; j_ < 2; ++j_) { \
        const unsigned d_ = (unsigned)__builtin_amdgcn_readfirstlane((int)(lds0 + (unsigned)((slot_) * SLOT + 256 * (8 * wid + 4 * j_)))); \
        glds16(kt_ + goff[j_], d_); glds16(kt_ + goff[j_] + 1024, d_ + VO); } } while (0)
    ATT_STAGE(0, 0); ATT_STAGE(1, 1);
    asm volatile("s_waitcnt vmcnt(0)" ::: "memory");
    __syncthreads();
    if (grpB) ATT_WAIT_BAR(0);
    const float sl2 = exp2f(-(float)(h + 1)) * LOG2E;
    const int swr = ((r32 & 3) << 2) | ((r32 >> 2) & 3);
    const LAS unsigned char* kbase = lds + 256 * r32;
    const int i16 = lane & 15, g1 = (lane >> 4) & 1;
    int vaddr[4][2];
#pragma unroll
    for (int db = 0; db < 4; ++db)
#pragma unroll
        for (int sec = 0; sec < 2; ++sec) { const int swv = ((i16 >> 2) << 2) | (hi + 2 * sec); const int ch = 4 * db + 2 * g1 + ((i16 & 3) >> 1);
            vaddr[db][sec] = VO + 256 * (4 * hi + (i16 >> 2) + 8 * sec) + 16 * (ch ^ swv) + 8 * (i16 & 1); }
    f32x16 o[4];
#pragma unroll
    for (int db = 0; db < 4; ++db)
#pragma unroll
        for (int i = 0; i < 16; ++i) o[db][i] = 0.f;
    float mref = 0.f, lsum = 0.f;
    int s0 = 0, s1 = 1, s2 = 2;
    for (int t = 0; t < NT; ++t) {
        if (grpB) ATT_STAGE(t + 2, s2);
        f32x16 p[2];
        const float nsl2 = -sl2, negm = -mref;
#pragma unroll
        for (int kh = 0; kh < 2; ++kh) {
            const float basef = (float)(qpos - 64 * t - 32 * kh - 4 * hi);
            f32x16 acc;
#define ATT_CI(i) acc[i] = a_bias(nsl2, a_subk<((i) & 3) + 8 * ((i) >> 2)>(basef), negm)
            ATT_CI(0); ATT_CI(1); ATT_CI(2); ATT_CI(3); ATT_CI(4); ATT_CI(5); ATT_CI(6); ATT_CI(7); ATT_CI(8); ATT_CI(9); ATT_CI(10); ATT_CI(11); ATT_CI(12); ATT_CI(13); ATT_CI(14); ATT_CI(15);
#undef ATT_CI
            asm volatile("s_nop 1" : "+v"(acc));
#pragma unroll
            for (int d0 = 0; d0 < 4; ++d0) { const int ch = c * 8 + d0 * 2 + hi;
                const bf16x8 kf = *(const LAS bf16x8*)(kbase + s0 * SLOT + kh * 8192 + 16 * (ch ^ swr));
                acc = MFMA32(kf, qf[d0], acc); }
            p[kh] = acc;
        }
        asm volatile("s_nop 15\n\ts_nop 7" : "+v"(p[0]), "+v"(p[1]));
        float rm;
        { float ra = a_max3(p[0][0], p[0][1], p[1][0]), rb = a_max3(p[0][2], p[0][3], p[1][1]); ra = a_max3(ra, p[1][2], p[1][3]);
#pragma unroll
          for (int i = 4; i < 16; i += 4) { ra = a_max3(ra, p[0][i], p[0][i + 1]); rb = a_max3(rb, p[0][i + 2], p[0][i + 3]); ra = a_max3(ra, p[1][i], p[1][i + 1]); rb = a_max3(rb, p[1][i + 2], p[1][i + 3]); }
          rm = fmaxf(ra, rb); }
        rm = half_swap_max(rm);
        if (t == 0 || __any(rm > 8.0f)) {
            const float delta = (t == 0) ? rm : fmaxf(rm, 0.f);
            mref += delta;
#pragma unroll
            for (int i = 0; i < 16; ++i) { p[0][i] = a_sub(p[0][i], delta); p[1][i] = a_sub(p[1][i], delta); }
            if (t != 0) { const float f = __builtin_amdgcn_exp2f(-delta); lsum *= f;
#pragma unroll
                for (int db = 0; db < 4; ++db) o[db] = o[db] * f; }
        }
        { float sa = 0.f, sb = 0.f;
#pragma unroll
          for (int i = 0; i < 16; ++i) { p[0][i] = __builtin_amdgcn_exp2f(p[0][i]); p[1][i] = __builtin_amdgcn_exp2f(p[1][i]); }
          asm volatile("s_nop 0" : "+v"(p[0]), "+v"(p[1]));
#pragma unroll
          for (int i = 0; i < 16; ++i) { sa = a_add(sa, p[0][i]); sb = a_add(sb, p[1][i]); }
          lsum = a_add(lsum, a_add(sa, sb)); }
        bf16x8 pfr[4];
#pragma unroll
        for (int kh = 0; kh < 2; ++kh)
#pragma unroll
            for (int sp = 0; sp < 2; ++sp) { u32x4 w; w.x = cvtpk_m(p[kh][8 * sp + 0], p[kh][8 * sp + 1]); w.y = cvtpk_m(p[kh][8 * sp + 2], p[kh][8 * sp + 3]); w.z = cvtpk_m(p[kh][8 * sp + 4], p[kh][8 * sp + 5]); w.w = cvtpk_m(p[kh][8 * sp + 6], p[kh][8 * sp + 7]);
                pfr[2 * kh + sp] = __builtin_bit_cast(bf16x8, w); }
        ATT_WAIT_BAR(4);
        if (!grpB) ATT_STAGE(t + 2, s2);
#pragma unroll
        for (int db = 0; db < 4; ++db)
#pragma unroll
            for (int s = 0; s < 4; ++s) { const LAS unsigned char* vb = lds + s0 * SLOT + 4096 * s;
                const s16x4 lo = vtr(vb + vaddr[db][0]), hi4 = vtr(vb + vaddr[db][1]);
                const bf16x8 vf = (bf16x8){lo[0], lo[1], lo[2], lo[3], hi4[0], hi4[1], hi4[2], hi4[3]};
                o[db] = MFMA32(vf, pfr[s], o[db]); }
        ATT_WAIT_BAR(4);
        { const int tmp = s0; s0 = s1; s1 = s2; s2 = tmp; }
    }
    if (!grpB) ATT_WAIT_BAR(0);
    asm volatile("s_waitcnt vmcnt(0)" ::: "memory");
    __syncthreads();
    const float lt = half_swap_sum(lsum);
    LAS float* xch = (LAS float*)(lds + qi * 16384) + lane;
    if (c == 1) { const float inv = lam / lt;
#pragma unroll
        for (int db = 0; db < 4; ++db)
#pragma unroll
            for (int i = 0; i < 16; ++i) xch[(db * 16 + i) * 64] = o[db][i] * inv; }
    __syncthreads();
    if (c == 0) {
        const float inv = 1.0f / lt; float ss = 0.f;
#pragma unroll
        for (int db = 0; db < 4; ++db)
#pragma unroll
            for (int i = 0; i < 16; ++i) { const float v = o[db][i] * inv - xch[(db * 16 + i) * 64]; o[db][i] = v; ss += v * v; }
        ss = half_swap_sum(ss);
        const float rstd = (1.0f / sqrtf(ss * (1.0f / 128.0f) + LN_EPS)) * 0.8f;
        bf16* orow = mix + (rowbase + qpos) * DM + h * 128;
#pragma unroll
        for (int db = 0; db < 4; ++db)
#pragma unroll
            for (int g = 0; g < 4; ++g) { const int d = 32 * db + 8 * g + 4 * hi; const f32x4 gg = *(const f32x4*)(subg + d);
                u32x2 w; w.x = pk2(o[db][4 * g] * rstd * gg.x, o[db][4 * g + 1] * rstd * gg.y); w.y = pk2(o[db][4 * g + 2] * rstd * gg.z, o[db][4 * g + 3] * rstd * gg.w);
                *(u32x2*)(orow + d) = w; }
    }
    __syncthreads();
}
#undef ATT_STAGE
}

namespace hy {
constexpr int CPS = 8224, VGO = 8 * CPS, VGS = 4112, RSTG = VGO + 8 * VGS;
#define MFMA16(a, b, c) __builtin_amdgcn_mfma_f32_16x16x32_bf16((a), (b), (c), 0, 0, 0)
__device__ __forceinline__ void conv_unit(LAS unsigned char* lds, int c, const bf16* filt, const bf16* vgT, const bf16* x1T, bf16* yT, const float* dskip) {
    const int tid = threadIdx.x, lane = tid & 63; const int wid = __builtin_amdgcn_readfirstlane(tid >> 6);
    *(LAS u32x4*)(lds + RSTG + tid * 16) = *(const u32x4*)(filt + (size_t)c * 4096 + tid * 8);
#pragma unroll
    for (int k = 0; k < 4; ++k) { const int id = tid + 512 * k, bb = id >> 8, ch = id & 255; *(LAS u32x4*)(lds + VGO + bb * VGS + ch * 16) = *(const u32x4*)(vgT + ((size_t)(c * 8 + bb)) * 2048 + ch * 8); }
    __syncthreads();
    { const LAS unsigned short* R = (const LAS unsigned short*)(lds + RSTG);
      for (int id = tid; id < 8 * 513; id += NTHR) { const int sh = id / 513, m = id - sh * 513; const int n0 = 8 * m - sh; unsigned w[4];
#pragma unroll
          for (int jj = 0; jj < 4; ++jj) { const int na = n0 + 2 * jj, nb = na + 1; const unsigned lo = (na >= 0 && na < 4096) ? (unsigned)R[na] : 0u; const unsigned hi = (nb >= 0 && nb < 4096) ? (unsigned)R[nb] : 0u; w[jj] = lo | (hi << 16); }
          *(LAS u32x4*)(lds + sh * CPS + m * 16) = (u32x4){w[0], w[1], w[2], w[3]}; } }
    __syncthreads();
    const int i = lane & 15, kq = lane >> 4;
    f32x4 acc[16];
#pragma unroll
    for (int a = 0; a < 16; ++a) acc[a] = (f32x4){0.f, 0.f, 0.f, 0.f};
    const LAS unsigned char* abase = lds + (i & 7) * CPS + 16 * (256 - 32 * wid - (i >> 3) + kq - 30);
    const LAS unsigned char* bbase = lds + VGO + (i & 7) * VGS + 16 * kq;
    for (int sc = 0; sc < 4; ++sc) {
        bf16x8 bfr[16];
#pragma unroll
        for (int ci = 0; ci < 16; ++ci) bfr[ci] = *(const LAS bf16x8*)(bbase + 64 * (16 * sc + ci));
        const LAS unsigned char* ab = abase + 1024 * sc;
#pragma unroll
        for (int vv = 0; vv < 46; ++vv) {
            const bf16x8 af = *(const LAS bf16x8*)(ab + 32 * vv);
#pragma unroll
            for (int ci = 0; ci < 16; ++ci) { const int ai = 2 * ci - (vv - 15); if (ai >= 0 && ai < 16) acc[ai] = MFMA16(af, bfr[ci], acc[ai]); }
        }
    }
    if (i < 8) {
        const float dsk = dskip[c];
#pragma unroll
        for (int ai = 0; ai < 16; ++ai) { const int t = 16 * (16 * wid + ai) + 4 * kq;
            const u32x2 vg = *(const LAS u32x2*)(lds + VGO + i * VGS + 2 * t); const u32x2 x1 = *(const u32x2*)(x1T + ((size_t)(c * 8 + i)) * 2048 + t);
            const float y0 = (acc[ai][0] + bflo(vg.x) * dsk) * bflo(x1.x), y1 = (acc[ai][1] + bfhi(vg.x) * dsk) * bfhi(x1.x), y2 = (acc[ai][2] + bflo(vg.y) * dsk) * bflo(x1.y), y3 = (acc[ai][3] + bfhi(vg.y) * dsk) * bfhi(x1.y);
            u32x2 w; w.x = pk2(y0, y1); w.y = pk2(y2, y3); *(u32x2*)(yT + ((size_t)(c * 8 + i)) * 2048 + t) = w; }
    }
    __syncthreads();
}
}

__device__ __forceinline__ void h3_item(Frame& F, int item) {
    constexpr int RS = 2064;
    const int b = item >> 6, t0 = (item & 63) * 32, tid = F.tid;
#pragma unroll
    for (int k = 0; k < 8; ++k) { const int id = tid + 512 * k, c = id >> 2, chunk = id & 3;
        const u32x4 v = *(const u32x4*)(F.yT + ((size_t)(c * 8 + b)) * 2048 + t0 + chunk * 8);
        LAS unsigned char* base = F.lds + (chunk * 8) * RS + c * 2;
        *(LAS unsigned short*)(base + 0 * RS) = (unsigned short)(v.x & 0xffffu); *(LAS unsigned short*)(base + 1 * RS) = (unsigned short)(v.x >> 16);
        *(LAS unsigned short*)(base + 2 * RS) = (unsigned short)(v.y & 0xffffu); *(LAS unsigned short*)(base + 3 * RS) = (unsigned short)(v.y >> 16);
        *(LAS unsigned short*)(base + 4 * RS) = (unsigned short)(v.z & 0xffffu); *(LAS unsigned short*)(base + 5 * RS) = (unsigned short)(v.z >> 16);
        *(LAS unsigned short*)(base + 6 * RS) = (unsigned short)(v.w & 0xffffu); *(LAS unsigned short*)(base + 7 * RS) = (unsigned short)(v.w >> 16); }
    __syncthreads();
    const int t_l = tid >> 4, cgp = tid & 15;
    u32x4 d[8]; float ss = 0.f;
#pragma unroll
    for (int k = 0; k < 8; ++k) { d[k] = *(const LAS u32x4*)(F.lds + t_l * RS + (16 * k + cgp) * 16);
#pragma unroll
        for (int e = 0; e < 4; ++e) { const float a = bflo(d[k][e]), bq = bfhi(d[k][e]); ss += a * a + bq * bq; } }
    ss += __shfl_xor(ss, 1); ss += __shfl_xor(ss, 2); ss += __shfl_xor(ss, 4); ss += __shfl_xor(ss, 8);
    const float rstd = 1.0f / sqrtf(ss * (1.0f / 1024.0f) + LN_EPS);
    bf16* orow = F.mix + ((size_t)(b * SEQ + t0 + t_l)) * DM + 1024;
#pragma unroll
    for (int k = 0; k < 8; ++k) { const int c0 = (16 * k + cgp) * 8; const f32x4 g0 = *(const f32x4*)(F.hgain + c0), g1 = *(const f32x4*)(F.hgain + c0 + 4);
        u32x4 w; w.x = pk2(bflo(d[k].x) * rstd * g0.x, bfhi(d[k].x) * rstd * g0.y); w.y = pk2(bflo(d[k].y) * rstd * g0.z, bfhi(d[k].y) * rstd * g0.w);
        w.z = pk2(bflo(d[k].z) * rstd * g1.x, bfhi(d[k].z) * rstd * g1.y); w.w = pk2(bflo(d[k].w) * rstd * g1.z, bfhi(d[k].w) * rstd * g1.w);
        *(u32x4*)(orow + c0) = w; }
    __syncthreads();
}
__device__ __forceinline__ void ln_rows(Frame& F, float* buf, const float* g, const float* bt, bf16* ob) {
    const int gw = blockIdx.x * NWAVES + F.wave, NGW = F.G * NWAVES;
    for (int m = gw; m < M; m += NGW) {
        f32x4* row = (f32x4*)(buf + (size_t)m * DM) + F.lane;
        f32x4 v[8]; float s = 0.f;
#pragma unroll
        for (int j = 0; j < 8; ++j) { v[j] = row[64 * j]; s += (v[j].x + v[j].y) + (v[j].z + v[j].w); }
        const float mean = wave_sum(s) * (1.0f / DM); float s2 = 0.f;
#pragma unroll
        for (int j = 0; j < 8; ++j) { v[j] = v[j] - mean; s2 += (v[j].x * v[j].x + v[j].y * v[j].y) + (v[j].z * v[j].z + v[j].w * v[j].w); }
        const float rstd = 1.0f / sqrtf(wave_sum(s2) * (1.0f / DM) + LN_EPS);
#pragma unroll
        for (int j = 0; j < 8; ++j) { const f32x4 gg = ((const f32x4*)g)[F.lane + 64 * j], bb = ((const f32x4*)bt)[F.lane + 64 * j]; const f32x4 y = v[j] * rstd * gg + bb; row[64 * j] = y;
            if (ob) { u32x2 w; w.x = pk2(y.x, y.y); w.y = pk2(y.z, y.w); *((u32x2*)(ob + (size_t)m * DM) + F.lane + 64 * j) = w; } }
    }
}
#define XB_TMO      128
#define XB_XCNT(j)  (256  + 64 * (j))
#define XB_XSUB(j)  (1280 + 64 * (j))
#define XB_XGEN(j)  (2304 + 64 * (j))
#define XB_TOP      3328
#define XB_TOPGEN   3392
#define XCD_BAR_WORDS 3456
#define XB_SPIN_CAP (1u << 18)

__device__ __forceinline__ unsigned xb_ld(unsigned* p)              { return __hip_atomic_load(p, __ATOMIC_RELAXED, __HIP_MEMORY_SCOPE_AGENT); }
__device__ __forceinline__ unsigned xb_add(unsigned* p, unsigned v) { return __hip_atomic_fetch_add(p, v, __ATOMIC_RELAXED, __HIP_MEMORY_SCOPE_AGENT); }
__device__ __forceinline__ unsigned xb_xcc_id() { return (unsigned)__builtin_amdgcn_s_getreg((3 << 11) | 20) & 0xFu; }
#define XB_SPIN(cond, bar) do { unsigned _sp = 0; while (cond) { __builtin_amdgcn_s_sleep(1); \
    if ((++_sp & 255u) == 0u) { if (xb_ld(&(bar)[XB_TMO])) break; if (_sp > XB_SPIN_CAP) { atomicAdd(&(bar)[XB_TMO], 1u); break; } } } } while (0)

struct XcdBarrier {
    unsigned* bar; unsigned x;
    volatile LAS unsigned* st;
};

__device__ __forceinline__ XcdBarrier xcd_barrier_post(unsigned* bar, volatile LAS unsigned* st) {
    XcdBarrier b; b.bar = bar; b.x = xb_xcc_id(); b.st = st;
    if (threadIdx.x == 0) (void)xb_add(&bar[XB_XCNT(b.x)], 1u);
    return b;
}
__device__ __forceinline__ void xcd_barrier_complete(unsigned* bar, unsigned x, unsigned& nloc, unsigned& nx) {
    const unsigned G = gridDim.x * gridDim.y * gridDim.z;
    unsigned sum, cnt, mine, sp = 0u;
    for (;;) {
        sum = 0u; cnt = 0u; mine = 0u;
#pragma unroll
        for (unsigned j = 0; j < 16; ++j) { const unsigned c = xb_ld(&bar[XB_XCNT(j)]); sum += c; cnt += (c > 0u) ? 1u : 0u; mine = (j == x) ? c : mine; }
        if (sum == G) break;
        __builtin_amdgcn_s_sleep(1);
        if ((++sp & 255u) == 0u) { if (xb_ld(&bar[XB_TMO])) break; if (sp > XB_SPIN_CAP) { atomicAdd(&bar[XB_TMO], 1u); break; } }
    }
    nloc = mine > 0u ? mine : 1u; nx = cnt > 0u ? cnt : 1u;
}

__device__ __forceinline__ void xcd_barrier(const XcdBarrier& b) {
    asm volatile("s_waitcnt vmcnt(0)" ::: "memory");
    __syncthreads();
    if (threadIdx.x == 0) {
        unsigned* bar = b.bar;
        __builtin_amdgcn_s_waitcnt(0);
        unsigned nloc = b.st[0], nx = b.st[1];
        if (nloc == 0u) { xcd_barrier_complete(bar, b.x, nloc, nx); b.st[0] = nloc; b.st[1] = nx; }
        const unsigned old = xb_add(&bar[XB_XSUB(b.x)], 1u);
        const unsigned gen = old / nloc;
        if (old + 1u == (gen + 1u) * nloc) {
            __builtin_amdgcn_fence(__ATOMIC_RELEASE, "agent");
            asm volatile("s_waitcnt vmcnt(0)" ::: "memory");
            const unsigned og = xb_add(&bar[XB_TOP], 1u);
            const unsigned tg = og / nx;
            if (og + 1u == (tg + 1u) * nx) xb_add(&bar[XB_TOPGEN], 1u);
            else XB_SPIN(xb_ld(&bar[XB_TOPGEN]) == tg, bar);
            __builtin_amdgcn_fence(__ATOMIC_ACQUIRE, "agent");
            xb_add(&bar[XB_XGEN(b.x)], 1u);
            asm volatile("s_waitcnt vmcnt(0)" ::: "memory");
        } else {
            XB_SPIN(xb_ld(&bar[XB_XGEN(b.x)]) == gen, bar);
            __builtin_amdgcn_fence(__ATOMIC_ACQUIRE, "agent");
            asm volatile("s_waitcnt vmcnt(0)" ::: "memory");
        }
    }
    __syncthreads();
}

__device__ __attribute__((noinline)) void xcd_barrier_ni(unsigned* bar, unsigned x, volatile LAS unsigned* st) { XcdBarrier b; b.bar = bar; b.x = x; b.st = st; xcd_barrier(b); }
struct Args { const float* in[24]; float* out; unsigned char* ws; int ph_lo, ph_hi; };
constexpr int N_PHASES = 10;
__global__ void __launch_bounds__(NTHR, 2) hymba_fwd(Args args) {
    extern __shared__ __attribute__((aligned(16))) unsigned char lds_raw[];
    Frame F;
    F.lds = (LAS unsigned char*)lds_raw;
    F.tid = threadIdx.x; F.lane = F.tid & 63; F.wave = __builtin_amdgcn_readfirstlane(F.tid >> 6);
    F.G = gridDim.x; { const int bx = blockIdx.x; F.vcu = (F.G % 8 == 0) ? (bx % 8) * (F.G / 8) + bx / 8 : bx; }
    unsigned char* ws = args.ws;
    F.x = args.in[0]; F.w_in = args.in[1]; F.lq1 = args.in[2]; F.lk1 = args.in[3]; F.lq2 = args.in[4]; F.lk2 = args.in[5]; F.subg = args.in[6]; F.conv_w = args.in[7]; F.conv_b = args.in[8];
    F.fw1 = args.in[9]; F.fb1 = args.in[10]; F.ffreq = args.in[11]; F.fw2 = args.in[12]; F.fb2 = args.in[13]; F.fw3 = args.in[14]; F.hskip = args.in[15]; F.hgain = args.in[16];
    F.w_out = args.in[17]; F.ln1g = args.in[18]; F.ln1b = args.in[19]; F.w_ff1 = args.in[20]; F.w_ff2 = args.in[21]; F.ln2g = args.in[22]; F.ln2b = args.in[23]; F.out = args.out;
    F.WinT = (bf16*)(ws + WS_WIN); F.WoutT = (bf16*)(ws + WS_WOUT); F.Wff1T = (bf16*)(ws + WS_WFF1); F.Wff2T = (bf16*)(ws + WS_WFF2);
    F.xb = (bf16*)(ws + WS_XB); F.mix = (bf16*)(ws + WS_XB); F.proj = (bf16*)(ws + WS_PROJ); F.x1b = (bf16*)(ws + WS_X1B); F.yT = (bf16*)(ws + WS_YT);
    F.vgT = (bf16*)(ws + WS_VGT); F.x1T = (bf16*)(ws + WS_X1T); F.filt = (bf16*)(ws + WS_FILT); F.hbuf = (bf16*)(ws + WS_H);
    const int lo = args.ph_lo, hi = args.ph_hi;
    if (F.tid < 64) ((LAS unsigned*)(F.lds + LDS_STAGE_BYTES))[F.tid] = 0u;
    __syncthreads();
    if (args.ph_hi > 1000) cg::this_grid().sync();
    XcdBarrier xbar = xcd_barrier_post((unsigned*)(ws + WS_CTL), (volatile LAS unsigned*)(F.lds + LDS_STAGE_BYTES) + 8);
#ifndef PHMASK
#define PHMASK 0x3ff
#endif
#define IN(k) ((((PHMASK) >> (k)) & 1) && lo <= (k) && (k) < hi)
#ifndef REPMASK
#define REPMASK 0
#endif
#define REP(k) for (int rep_ = 0; rep_ < ((((REPMASK) >> (k)) & 1) ? 2 : 1); ++rep_)
#define SEAM(k) do { if (IN(k) && IN((k) + 1)) xcd_barrier_ni(xbar.bar, xbar.x, xbar.st); } while (0)

    if (IN(0)) REP(0) {
        { LAS float* scr = (LAS float*)(F.lds + F.wave * 8704);
          const int gw = F.vcu * NWAVES + F.wave, NGW = F.G * NWAVES;
          constexpr int I_IN = (DM / 64) * (INC / 32), I_OUT = (DM / 64) * (DM / 32), I_F1 = (DM / 64) * (DFF / 32), I_F2 = (DFF / 64) * (DM / 32);
          for (int it = gw; it < I_IN + I_OUT + I_F1 + I_F2; it += NGW) { int r = it;
              if (r < I_IN) { p0_transpose_item(F.w_in, DM, INC, F.WinT, scr, r, F.lane); continue; } r -= I_IN;
              if (r < I_OUT) { p0_transpose_item(F.w_out, DM, DM, F.WoutT, scr, r, F.lane); continue; } r -= I_OUT;
              if (r < I_F1) { p0_transpose_item(F.w_ff1, DM, DFF, F.Wff1T, scr, r, F.lane); continue; } r -= I_F1;
              p0_transpose_item(F.w_ff2, DFF, DM, F.Wff2T, scr, r, F.lane); } }
        __syncthreads();
        for (int it = blockIdx.x; it < SEQ / 16; it += F.G) filter_item(F, it);
        { const size_t nchunk = (size_t)M * DM / 8; const f32x4* x4 = (const f32x4*)F.x; u32x4* xo = (u32x4*)F.xb;
          for (size_t ch = (size_t)blockIdx.x * NTHR + F.tid; ch < nchunk; ch += (size_t)F.G * NTHR) { const f32x4 a = x4[2 * ch], b = x4[2 * ch + 1]; u32x4 o; o.x = pk2(a.x, a.y); o.y = pk2(a.z, a.w); o.z = pk2(b.x, b.y); o.w = pk2(b.z, b.w); xo[ch] = o; } }
    }
    SEAM(0);
    if (IN(1)) REP(1) {
        pg8::Gemm g{F.xb, F.WinT, M, INC, DM}; pg8::StaticOrder S; S.init(M, INC, F.G, (int)blockIdx.x);
        pg8::EpiBf16<0> E{F.proj, INC, 1024, QSCALE};
        pg8::gemm_phase<pg8::EpiBf16<0>, pg8::StaticOrder, true, true>(F.lds, g, S, E);
    }
    SEAM(1);
    if (IN(2)) REP(2) { for (int it = blockIdx.x; it < 4096; it += F.G) h1_item(F, it); }
    SEAM(2);
    if (IN(3)) REP(3) {
        float sa = F.lq1[F.lane] * F.lk1[F.lane], sb = F.lq2[F.lane] * F.lk2[F.lane]; sa = wave_sum(sa); sb = wave_sum(sb);
        const float lam = __expf(sa) - __expf(sb) + 0.2f;
#ifndef REP_ATT
#define REP_ATT 1
#endif
#ifndef REP_HY
#define REP_HY 1
#endif
#ifndef NO_ATT
        for (int ra_ = 0; ra_ < REP_ATT; ++ra_) for (int u = F.vcu; u < 1024; u += F.G) att::attn_unit(F.lds, F.proj, F.mix, u >> 7, (u >> 4) & 7, u & 15, lam, F.subg);
#endif
#ifndef NO_HY
        for (int rh_ = 0; rh_ < REP_HY; ++rh_) for (int c = F.vcu; c < NCH; c += F.G) hy::conv_unit(F.lds, c, F.filt, F.vgT, F.x1T, F.yT, F.hskip);
#endif
    }
    SEAM(3);
    if (IN(4)) REP(4) { for (int it = blockIdx.x; it < 512; it += F.G) h3_item(F, it); }
    SEAM(4);
    if (IN(5)) REP(5) {
        pg8::Gemm g{F.mix, F.WoutT, M, DM, DM}; pg8::StaticOrder S; S.init(M, DM, F.G, (int)blockIdx.x);
        pg8::EpiResF32 E{F.x, F.out, DM, ALPHA};
        pg8::gemm_phase<pg8::EpiResF32, pg8::StaticOrder, true, true>(F.lds, g, S, E);
    }
    SEAM(5);
    if (IN(6)) ln_rows(F, F.out, F.ln1g, F.ln1b, F.x1b);
    SEAM(6);
    if (IN(7)) REP(7) {
        pg8::Gemm g{F.x1b, F.Wff1T, M, DFF, DM}; pg8::StaticOrder S; S.init(M, DFF, F.G, (int)blockIdx.x);
        pg8::EpiBf16<2> E{F.hbuf, DFF, 0, 1.f};
        pg8::gemm_phase<pg8::EpiBf16<2>, pg8::StaticOrder, true, true>(F.lds, g, S, E);
    }
    SEAM(7);
    if (IN(8)) {
        pg8::Gemm g{F.hbuf, F.Wff2T, M, DM, DFF}; pg8::StaticOrder S; S.init(M, DM, F.G, (int)blockIdx.x);
        pg8::EpiResF32 E{F.out, F.out, DM, ALPHA};
        pg8::gemm_phase<pg8::EpiResF32, pg8::StaticOrder, true, true>(F.lds, g, S, E);
    }
    SEAM(8);
#ifdef EXTRA_SYNCS
    for (int es_ = 0; es_ < EXTRA_SYNCS; ++es_) cg::this_grid().sync();
#endif
    if (IN(9)) ln_rows(F, F.out, F.ln2g, F.ln2b, nullptr);
#undef IN
#undef SEAM
}

#ifndef MK_N_LAUNCHES
#define MK_N_LAUNCHES 1
#endif
extern "C" void kernel_launch(void* const* d_in, const int* in_sizes, int n_in, void* d_out, int out_size, void* d_ws, size_t ws_size, hipStream_t stream) {
    static int grid = 0;
    if (grid == 0) {
        if (n_in != 24 || in_sizes[0] != M * DM || out_size != M * DM || ws_size < WS_END) { fprintf(stderr, "kernel_launch: unexpected problem shape (n_in %d, in0 %d, out %d, ws %zu); nothing launched\n", n_in, n_in > 0 ? in_sizes[0] : -1, out_size, ws_size); grid = -1; return; }
        int dev = 0, cus = 0, per_cu = 0;
        if (hipGetDevice(&dev) != hipSuccess || hipDeviceGetAttribute(&cus, hipDeviceAttributeMultiprocessorCount, dev) != hipSuccess) { grid = -1; return; }
        if (hipFuncSetAttribute((const void*)hymba_fwd, hipFuncAttributeMaxDynamicSharedMemorySize, LDS_BYTES) != hipSuccess) { fprintf(stderr, "kernel_launch: hipFuncSetAttribute failed\n"); grid = -1; return; }
        if (hipOccupancyMaxActiveBlocksPerMultiprocessor(&per_cu, (const void*)hymba_fwd, NTHR, LDS_BYTES) != hipSuccess || per_cu < 1) { fprintf(stderr, "kernel_launch: occupancy query says %d blocks per CU\n", per_cu); per_cu = 1; }
        (void)hipGetLastError();
        grid = cus * per_cu;
    }
    if (grid < 0) return;
    if (hipMemsetAsync((char*)d_ws + WS_CTL, 0, CTL_ZERO_BYTES, stream) != hipSuccess) { fprintf(stderr, "kernel_launch: hipMemsetAsync failed\n"); return; }
    Args a{};
    for (int i = 0; i < 24; ++i) a.in[i] = (const float*)d_in[i];
    a.out = (float*)d_out; a.ws = (unsigned char*)d_ws;
#if MK_N_LAUNCHES == 1
    a.ph_lo = 0; a.ph_hi = N_PHASES;
    void* kargs[] = {&a};
    const hipError_t e = hipLaunchCooperativeKernel((const void*)hymba_fwd, dim3(grid), dim3(NTHR), kargs, LDS_BYTES, stream);
    if (e != hipSuccess) fprintf(stderr, "kernel_launch: cooperative launch failed: %s (grid %d)\n", hipGetErrorString(e), grid);
#else
    for (int p = 0; p < N_PHASES; ++p) { a.ph_lo = p; a.ph_hi = p + 1; hipLaunchKernelGGL(hymba_fwd, dim3(grid), dim3(NTHR), LDS_BYTES, stream, a); }
#endif
}
```
